# Optimizing an MI355X kernel written in HIP

```python
import math
import jax, jax.numpy as jnp
from jax import lax
import numpy as np

D_MODEL = 2048
BATCH = 1
SEQ = 8192
DEPTH = 4

W_SSM = 1024
SSM_GROUP = 16
SSM_GROUPS = W_SSM // SSM_GROUP
SSM_STATE = 64
SSM_STEP_MIN = 1e-3
SSM_STEP_MAX = 1e-1
W_RET = 1024
RET_HEADS = 8
RET_HEAD_DIM = W_RET // RET_HEADS
RET_CHUNK = 128
ROPE_BASE = 10000.0
W_RWKV = 1024
RWKV_HEAD_DIM = 64
RWKV_HEADS = W_RWKV // RWKV_HEAD_DIM
RWKV_DECAY_RANK = 64
RWKV_A_RANK = 64
RWKV_GATE_RANK = 128
RWKV_LO = RWKV_DECAY_RANK + RWKV_A_RANK + RWKV_GATE_RANK
RWKV_IN = 3 * W_RWKV + RWKV_LO
N_BRANCH = 3
D_FF = 5632
CONV_WIDTH = 3
OFF_SSM = 0
OFF_RET = OFF_SSM + W_SSM
OFF_RWKV = OFF_RET + 4 * W_RET
OFF_GATE = OFF_RWKV + RWKV_IN
N_IN = OFF_GATE + N_BRANCH * D_MODEL
DEEPNORM_ALPHA = (2.0 * DEPTH) ** 0.25
DEEPNORM_BETA = (8.0 * DEPTH) ** -0.25
LN_EPS = 1e-5
GN_EPS = 1e-5
RWKV_GN_EPS = 64e-5

kernel_name = "hybrid_s5_retnet_rwkv7_deepnorm"


def layer_norm(x, g, b):
    xf = x.astype(jnp.float32)
    mu = xf.mean(-1, keepdims=True)
    var = jnp.mean(jnp.square(xf - mu), -1, keepdims=True)
    return ((xf - mu) * lax.rsqrt(var + LN_EPS) * g + b).astype(x.dtype)


def head_norm(y, g, b, n_heads, eps):
    bsz, t, w = y.shape
    yh = y.astype(jnp.float32).reshape(bsz, t, n_heads, w // n_heads)
    mu = yh.mean(-1, keepdims=True)
    var = jnp.mean(jnp.square(yh - mu), -1, keepdims=True)
    return ((yh - mu) * lax.rsqrt(var + eps)).reshape(bsz, t, w) * g + b


def shift_right(z):
    return jnp.pad(z[:, :-1], ((0, 0), (1, 0), (0, 0)))


def causal_dwconv(h, w):
    kw = w.shape[0]
    t = h.shape[1]
    hp = jnp.pad(h, ((0, 0), (kw - 1, 0), (0, 0)))
    out = hp[:, 0:t] * w[0]
    for j in range(1, kw):
        out = out + hp[:, j:j + t] * w[j]
    return out


def rotary(x, positions):
    half = x.shape[-1] // 2
    inv_freq = ROPE_BASE ** (-jnp.arange(half, dtype=jnp.float32) / half)
    ang = positions.astype(jnp.float32)[..., None] * inv_freq
    cos = jnp.cos(ang)[:, :, None, :]
    sin = jnp.sin(ang)[:, :, None, :]
    x1, x2 = x[..., :half], x[..., half:]
    return jnp.concatenate([x1 * cos - x2 * sin, x2 * cos + x1 * sin], axis=-1)


def s5_branch(u, lam_re, lam_im, log_step, b_re, b_im, c_re, c_im, d_skip, w_glu):
    bsz, t, _ = u.shape
    uf = u.astype(jnp.float32)
    ug = uf.reshape(bsz, t, SSM_GROUPS, SSM_GROUP)
    step = jnp.exp(log_step.astype(jnp.float32))[:, None]
    lr = lam_re.astype(jnp.float32)
    li = lam_im.astype(jnp.float32)
    mag = jnp.exp(lr * step)
    ab_re = mag * jnp.cos(li * step)
    ab_im = mag * jnp.sin(li * step)
    denom = lr * lr + li * li
    f_re = ((ab_re - 1.0) * lr + ab_im * li) / denom
    f_im = (ab_im * lr - (ab_re - 1.0) * li) / denom
    bb_re = f_re[..., None] * b_re - f_im[..., None] * b_im
    bb_im = f_re[..., None] * b_im + f_im[..., None] * b_re
    bu_re = jnp.einsum('btgc,gpc->btgp', ug, bb_re)
    bu_im = jnp.einsum('btgc,gpc->btgp', ug, bb_im)
    a_re = jnp.broadcast_to(ab_re, bu_re.shape)
    a_im = jnp.broadcast_to(ab_im, bu_re.shape)

    def combine(e1, e2):
        a1r, a1i, b1r, b1i = e1
        a2r, a2i, b2r, b2i = e2
        return (a2r * a1r - a2i * a1i,
                a2r * a1i + a2i * a1r,
                a2r * b1r - a2i * b1i + b2r,
                a2r * b1i + a2i * b1r + b2i)

    _, _, s_re, s_im = lax.associative_scan(combine, (a_re, a_im, bu_re, bu_im), axis=1)
    y = (jnp.einsum('btgp,gcp->btgc', s_re, c_re)
         - jnp.einsum('btgp,gcp->btgc', s_im, c_im))
    y = y.reshape(bsz, t, W_SSM) + d_skip * uf
    z = jax.nn.gelu(y).astype(u.dtype)
    h = z @ w_glu
    return h[..., :D_MODEL] * jax.nn.sigmoid(h[..., D_MODEL:])


def retention_branch(q, k, v, g, positions, norm_g, norm_b, w_out):
    bsz, t, _ = q.shape
    c = RET_CHUNK
    n = t // c

    def heads(z):
        return z.astype(jnp.float32).reshape(bsz, t, RET_HEADS, RET_HEAD_DIM)

    qh = rotary(heads(q), positions)
    kh = rotary(heads(k), positions) * (RET_HEAD_DIM ** -0.5)
    vh = heads(v)
    qh = qh.reshape(bsz, n, c, RET_HEADS, RET_HEAD_DIM)
    kh = kh.reshape(bsz, n, c, RET_HEADS, RET_HEAD_DIM)
    vh = vh.reshape(bsz, n, c, RET_HEADS, RET_HEAD_DIM)
    log_gamma = jnp.log1p(-jnp.exp2(-5.0 - jnp.arange(RET_HEADS, dtype=jnp.float32)))
    idx = jnp.arange(c, dtype=jnp.float32)
    rel = idx[:, None] - idx[None, :]
    decay = jnp.where(rel >= 0, jnp.exp(log_gamma[:, None, None] * jnp.maximum(rel, 0.0)), 0.0)
    scores = jnp.einsum('bnihd,bnjhd->bnhij', qh, kh) * decay
    inner = jnp.einsum('bnhij,bnjhe->bnihe', scores, vh)
    k_decay = jnp.exp(log_gamma[None, :] * (c - 1.0 - idx)[:, None])
    kv = jnp.einsum('bnjhd,jh,bnjhe->nbhde', kh, k_decay, vh)
    chunk_decay = jnp.exp(log_gamma * c)[None, :, None, None]

    def step(state, kv_n):
        return chunk_decay * state + kv_n, state

    init = jnp.zeros((bsz, RET_HEADS, RET_HEAD_DIM, RET_HEAD_DIM), jnp.float32)
    _, prev = lax.scan(step, init, kv)
    q_decay = jnp.exp(log_gamma[None, :] * (idx + 1.0)[:, None])
    cross = jnp.einsum('bnihd,nbhde->bnihe', qh, prev) * q_decay[:, :, None]
    o = (inner + cross).reshape(bsz, t, W_RET)
    o = head_norm(o, norm_g, norm_b, RET_HEADS, GN_EPS)
    o = jax.nn.silu(g.astype(jnp.float32)) * o
    return o.astype(q.dtype) @ w_out


def rwkv7_branch(z, mu, w0, w2, a0, a2, g2, k_k, k_a, r_k, norm_g, norm_b, w_out):
    bsz, t, _ = z.shape
    zf = z.astype(jnp.float32)
    zs = zf + mu * (shift_right(zf) - zf)
    r = zs[..., 0:W_RWKV]
    k = zs[..., W_RWKV:2 * W_RWKV]
    v = zs[..., 2 * W_RWKV:3 * W_RWKV]
    o0 = 3 * W_RWKV
    w_lo = zs[..., o0:o0 + RWKV_DECAY_RANK]
    a_lo = zs[..., o0 + RWKV_DECAY_RANK:o0 + RWKV_DECAY_RANK + RWKV_A_RANK]
    g_lo = zs[..., o0 + RWKV_DECAY_RANK + RWKV_A_RANK:RWKV_IN]
    w = -jax.nn.softplus(-(w0 + jnp.tanh(w_lo) @ w2)) - 0.5
    decay = jnp.exp(-jnp.exp(w))
    a = jax.nn.sigmoid(a0 + a_lo @ a2)
    g = jax.nn.sigmoid(g_lo) @ g2

    def heads(y):
        return y.reshape(bsz, t, RWKV_HEADS, RWKV_HEAD_DIM)

    kk = heads(k * k_k)
    kk = kk / jnp.maximum(jnp.sqrt(jnp.sum(kk * kk, -1, keepdims=True)), 1e-12)
    k = k * (1.0 + (a - 1.0) * k_a)
    rh, kh, vh, ah, wh = heads(r), heads(k), heads(v), heads(a), heads(decay)

    def tmajor(y):
        return jnp.moveaxis(y, 1, 0)

    def step(S, inp):
        r_t, w_t, k_t, v_t, kk_t, a_t = inp
        sa = jnp.einsum('bhvk,bhk->bhv', S, -kk_t)
        S = (S * w_t[:, :, None, :] + sa[..., None] * (kk_t * a_t)[:, :, None, :]
             + v_t[..., None] * k_t[:, :, None, :])
        return S, jnp.einsum('bhvk,bhk->bhv', S, r_t)

    init = jnp.zeros((bsz, RWKV_HEADS, RWKV_HEAD_DIM, RWKV_HEAD_DIM), jnp.float32)
    xs = (tmajor(rh), tmajor(wh), tmajor(kh), tmajor(vh), tmajor(kk), tmajor(ah))
    _, y = lax.scan(step, init, xs)
    y = jnp.moveaxis(y, 0, 1).reshape(bsz, t, W_RWKV)
    y = head_norm(y, norm_g, norm_b, RWKV_HEADS, RWKV_GN_EPS)
    bonus = jnp.sum(rh * kh * r_k.reshape(RWKV_HEADS, RWKV_HEAD_DIM), -1, keepdims=True) * vh
    o = (y + bonus.reshape(bsz, t, W_RWKV)) * g
    return o.astype(z.dtype) @ w_out


def conv_ffn(x, w_up, w_conv, w_down):
    h = causal_dwconv(x @ w_up, w_conv)
    return (jax.nn.silu(h[..., :D_FF]) * h[..., D_FF:]) @ w_down


def setup_inputs(seed: int = 0) -> dict:
    key = jax.random.key(seed)
    ks = jax.random.split(key, 40)
    f32 = jnp.float32
    L = DEPTH

    def nrm(k, shape, scale):
        return jax.random.normal(k, shape, f32) * scale

    def unif(k, shape, lo, hi):
        return jax.random.uniform(k, shape, f32, lo, hi)

    inp = {}
    inp["x"] = nrm(ks[0], (BATCH, SEQ, D_MODEL), 1.0)
    inp["positions"] = jnp.broadcast_to(jnp.arange(SEQ, dtype=jnp.int32), (BATCH, SEQ))
    inp["w_in"] = nrm(ks[1], (L, D_MODEL, N_IN), D_MODEL ** -0.5)
    inp["ssm_lambda_re"] = -0.5 + nrm(ks[2], (L, SSM_GROUPS, SSM_STATE), 0.01)
    inp["ssm_lambda_im"] = (math.pi * jnp.arange(SSM_STATE, dtype=f32)
                            + nrm(ks[3], (L, SSM_GROUPS, SSM_STATE), 0.01))
    inp["ssm_log_step"] = unif(ks[4], (L, SSM_GROUPS), math.log(SSM_STEP_MIN), math.log(SSM_STEP_MAX))
    inp["ssm_b_re"] = nrm(ks[5], (L, SSM_GROUPS, SSM_STATE, SSM_GROUP), (2.0 * SSM_GROUP) ** -0.5)
    inp["ssm_b_im"] = nrm(ks[6], (L, SSM_GROUPS, SSM_STATE, SSM_GROUP), (2.0 * SSM_GROUP) ** -0.5)
    inp["ssm_c_re"] = nrm(ks[7], (L, SSM_GROUPS, SSM_GROUP, SSM_STATE), (2.0 / SSM_STATE) ** 0.5)
    inp["ssm_c_im"] = nrm(ks[8], (L, SSM_GROUPS, SSM_GROUP, SSM_STATE), (2.0 / SSM_STATE) ** 0.5)
    inp["ssm_d"] = nrm(ks[9], (L, W_SSM), 1.0)
    inp["ssm_glu"] = nrm(ks[10], (L, W_SSM, 2 * D_MODEL), W_SSM ** -0.5)
    inp["ret_norm_g"] = 1.0 + nrm(ks[11], (L, W_RET), 0.02)
    inp["ret_norm_b"] = nrm(ks[12], (L, W_RET), 0.02)
    inp["ret_out"] = nrm(ks[13], (L, W_RET, D_MODEL), W_RET ** -0.5)
    inp["rwkv_mu"] = unif(ks[14], (L, RWKV_IN), 0.0, 1.0)
    inp["rwkv_w0"] = unif(ks[15], (L, W_RWKV), -6.0, -1.0)
    inp["rwkv_w2"] = nrm(ks[16], (L, RWKV_DECAY_RANK, W_RWKV), 0.1 * RWKV_DECAY_RANK ** -0.5)
    inp["rwkv_a0"] = nrm(ks[17], (L, W_RWKV), 0.1)
    inp["rwkv_a2"] = nrm(ks[18], (L, RWKV_A_RANK, W_RWKV), RWKV_A_RANK ** -0.5)
    inp["rwkv_g2"] = nrm(ks[19], (L, RWKV_GATE_RANK, W_RWKV), RWKV_GATE_RANK ** -0.5)
    inp["rwkv_k_k"] = 0.85 + nrm(ks[20], (L, W_RWKV), 0.05)
    inp["rwkv_k_a"] = 1.0 + nrm(ks[21], (L, W_RWKV), 0.05)
    inp["rwkv_r_k"] = nrm(ks[22], (L, W_RWKV), 0.1)
    inp["rwkv_norm_g"] = 1.0 + nrm(ks[23], (L, W_RWKV), 0.02)
    inp["rwkv_norm_b"] = nrm(ks[24], (L, W_RWKV), 0.02)
    inp["rwkv_out"] = nrm(ks[25], (L, W_RWKV, D_MODEL), W_RWKV ** -0.5)
    inp["w_o"] = nrm(ks[26], (L, D_MODEL, D_MODEL), DEEPNORM_BETA * D_MODEL ** -0.5)
    inp["ln1_g"] = 1.0 + nrm(ks[27], (L, D_MODEL), 0.02)
    inp["ln1_b"] = nrm(ks[28], (L, D_MODEL), 0.02)
    inp["ffn_up"] = nrm(ks[29], (L, D_MODEL, 2 * D_FF), D_MODEL ** -0.5)
    inp["ffn_conv"] = nrm(ks[30], (L, CONV_WIDTH, 2 * D_FF), CONV_WIDTH ** -0.5)
    inp["ffn_down"] = nrm(ks[31], (L, D_FF, D_MODEL), DEEPNORM_BETA * D_FF ** -0.5)
    inp["ln2_g"] = 1.0 + nrm(ks[32], (L, D_MODEL), 0.02)
    inp["ln2_b"] = nrm(ks[33], (L, D_MODEL), 0.02)
    return inp


def reference(x, positions, w_in, ssm_lambda_re, ssm_lambda_im, ssm_log_step, ssm_b_re, ssm_b_im,
              ssm_c_re, ssm_c_im, ssm_d, ssm_glu, ret_norm_g, ret_norm_b, ret_out, rwkv_mu, rwkv_w0,
              rwkv_w2, rwkv_a0, rwkv_a2, rwkv_g2, rwkv_k_k, rwkv_k_a, rwkv_r_k, rwkv_norm_g, rwkv_norm_b,
              rwkv_out, w_o, ln1_g, ln1_b, ffn_up, ffn_conv, ffn_down, ln2_g, ln2_b):
    bsz, t, _ = x.shape
    for l in range(DEPTH):
        proj = x @ w_in[l]
        y_ssm = s5_branch(proj[..., OFF_SSM:OFF_RET], ssm_lambda_re[l], ssm_lambda_im[l],
                          ssm_log_step[l], ssm_b_re[l], ssm_b_im[l], ssm_c_re[l], ssm_c_im[l],
                          ssm_d[l], ssm_glu[l])
        y_ret = retention_branch(proj[..., OFF_RET:OFF_RET + W_RET],
                                 proj[..., OFF_RET + W_RET:OFF_RET + 2 * W_RET],
                                 proj[..., OFF_RET + 2 * W_RET:OFF_RET + 3 * W_RET],
                                 proj[..., OFF_RET + 3 * W_RET:OFF_RWKV],
                                 positions, ret_norm_g[l], ret_norm_b[l], ret_out[l])
        y_rwkv = rwkv7_branch(proj[..., OFF_RWKV:OFF_GATE], rwkv_mu[l], rwkv_w0[l], rwkv_w2[l],
                              rwkv_a0[l], rwkv_a2[l], rwkv_g2[l], rwkv_k_k[l], rwkv_k_a[l],
                              rwkv_r_k[l], rwkv_norm_g[l], rwkv_norm_b[l], rwkv_out[l])
        gates = jax.nn.sigmoid(proj[..., OFF_GATE:].astype(jnp.float32)).reshape(bsz, t, N_BRANCH, D_MODEL)
        merged = gates[:, :, 0] * y_ssm + gates[:, :, 1] * y_ret + gates[:, :, 2] * y_rwkv
        x = layer_norm(DEEPNORM_ALPHA * x + merged.astype(x.dtype) @ w_o[l], ln1_g[l], ln1_b[l])
        x = layer_norm(DEEPNORM_ALPHA * x + conv_ffn(x, ffn_up[l], ffn_conv[l], ffn_down[l]),
                       ln2_g[l], ln2_b[l])
    return x
```

```cpp
#include <hip/hip_runtime.h>
#include <cstdio>
#include <cstdint>

#define GAS __attribute__((address_space(1)))
#define LAS __attribute__((address_space(3)))
#ifndef RESID_LO
#define RESID_LO 1
#endif
typedef unsigned short bf16;
typedef short bf16x8 __attribute__((ext_vector_type(8)));
typedef float f32x4 __attribute__((ext_vector_type(4)));
typedef float f32x2 __attribute__((ext_vector_type(2)));
typedef unsigned u32x4 __attribute__((ext_vector_type(4)));
typedef unsigned u32x2 __attribute__((ext_vector_type(2)));

constexpr int T = 8192, D = 2048, DEPTH = 4;
constexpr int NIN = 14592, OFF_RET = 1024, OFF_RWKV = 5120, OFF_GATE = 8448;
constexpr int RWKV_IN = 3328, DFF = 5632;
constexpr float DN_ALPHA = 1.6817928305074290f;
constexpr float LN_EPS = 1e-5f, GN_EPS = 1e-5f, RWKV_GN_EPS = 64e-5f;

__device__ __forceinline__ float bf_lo(unsigned u) { return __uint_as_float(u << 16); }
__device__ __forceinline__ float bf_hi(unsigned u) { return __uint_as_float(u & 0xffff0000u); }
__device__ __forceinline__ float bf2f(bf16 b) { return __uint_as_float(((unsigned)b) << 16); }
typedef __bf16 bf16x2v __attribute__((ext_vector_type(2)));
__device__ __forceinline__ unsigned cvt_pk_bf16(float lo, float hi) { return __builtin_bit_cast(unsigned, __builtin_convertvector((f32x2){lo, hi}, bf16x2v)); }
__device__ __forceinline__ bf16 f2bf(float f) { return (bf16)(cvt_pk_bf16(f, 0.f) & 0xffffu); }
__device__ __forceinline__ u32x4 pack8(const f32x4 a, const f32x4 b) { u32x4 w; w.x = cvt_pk_bf16(a[0], a[1]); w.y = cvt_pk_bf16(a[2], a[3]); w.z = cvt_pk_bf16(b[0], b[1]); w.w = cvt_pk_bf16(b[2], b[3]); return w; }
__device__ __forceinline__ void unpack8(const u32x4 w, f32x4& a, f32x4& b) { a = (f32x4){bf_lo(w.x), bf_hi(w.x), bf_lo(w.y), bf_hi(w.y)}; b = (f32x4){bf_lo(w.z), bf_hi(w.z), bf_lo(w.w), bf_hi(w.w)}; }
__device__ __forceinline__ float sigm(float x) { return __builtin_amdgcn_rcpf(1.f + __expf(-x)); }
__device__ __forceinline__ f32x4 sigm4(f32x4 x) { return (f32x4){sigm(x[0]), sigm(x[1]), sigm(x[2]), sigm(x[3])}; }
__device__ __forceinline__ float gelu_tanh(float y) { const float z = 1.5957691216057308f * (y + 0.044715f * y * y * y); return y * sigm(z); }
__device__ __forceinline__ float ex2(float x) { return __builtin_amdgcn_exp2f(x); }
__device__ __forceinline__ float l2gamma(int h) {
    return h == 0 ? -0.04580368961312479f : h == 1 ? -0.02272007650008353f : h == 2 ? -0.011315313227834146f : h == 3 ? -0.005646563141142063f
         : h == 4 ? -0.0028205190623786626f : h == 5 ? -0.0014095702546713536f : h == 6 ? -0.0007046129765893727f : -0.0003522634716290214f;
}
__device__ __forceinline__ void sincos_cw(float x, float& sn, float& cs) {
    const float n = rintf(x * 0.6366197723675814f);
    float r = fmaf(-n, 1.570796251296997f, x); r = fmaf(-n, 7.549790126404332e-08f, r);
    const float r2 = r * r;
    const float sp = r + r * r2 * (-1.6666654611e-1f + r2 * (8.3321608736e-3f + r2 * (-1.9515295891e-4f)));
    const float cp = 1.f - 0.5f * r2 + r2 * r2 * (4.166664568298827e-2f + r2 * (-1.388731625493765e-3f + r2 * 2.443315711809948e-5f));
    const int q = (int)n & 3;
    sn = (q == 0) ? sp : (q == 1) ? cp : (q == 2) ? -sp : -cp;
    cs = (q == 0) ? cp : (q == 1) ? -sp : (q == 2) ? -cp : sp;
}
__device__ __forceinline__ float rsq(float x) { return __builtin_amdgcn_rsqf(x); }
__device__ __forceinline__ float softplus_f(float x) { return fmaxf(x, 0.f) + __logf(1.f + __expf(-fabsf(x))); }

namespace pg8 {
constexpr int BM = 256, BK = 64, HALF = 128, HTB = HALF * BK * 2, STAGE_BYTES = 8 * HTB, NXCD = 8, WGM = 8;
__host__ __device__ __forceinline__ int lds_byte(int r, int c) { const int st = (r >> 4) * 2 + (c >> 5), rr = r & 15, cc = c & 31, ob = rr * 64 + cc * 2; return st * 1024 + (ob ^ (((ob >> 9) & 1) << 5)); }
__host__ __device__ __forceinline__ void stage_rc(int b, int& R, int& C) { const int st = b / 1024, sb = b % 1024, swz = sb ^ (((sb >> 9) & 1) << 5); R = (st >> 1) * 16 + swz / 64; C = (st & 1) * 32 + (swz % 64) / 2; }
__host__ __device__ __forceinline__ int perm32(int rho) { const int n = rho >> 4, i = rho & 15; return 8 * (i >> 2) + 4 * n + (i & 3); }

struct Unit { int pm, pn, kind; };
struct Gemm { const GAS bf16* A; const GAS bf16* Bt; int lda, ldb, K; int mstep = 256; const GAS bf16* A2 = nullptr; const GAS bf16* Bt2 = nullptr; };

struct StaticOrder {
    int nM, nN, nwg, G, c;
    __device__ void init(int nM_, int nN_, int G_, int c_) { nM = nM_; nN = nN_; nwg = nM * nN; G = G_; c = c_; }
    __device__ bool next(int i, Unit& u) const {
        const long L = (long)i * G + c; if (L >= nwg) return false;
        int wgid = (int)L; { const int q = nwg / NXCD, r = nwg % NXCD, xcd = wgid % NXCD, off = wgid / NXCD; wgid = (xcd < r ? xcd * (q + 1) : r * (q + 1) + (xcd - r) * q) + off; }
        const int nig = WGM * nN, gid = wgid / nig, fm = gid * WGM, gsz = (nM - fm) < WGM ? (nM - fm) : WGM;
        u.pm = fm + ((wgid % nig) % gsz); u.pn = (wgid % nig) / gsz; u.kind = 0; return true;
    }
};
template <class Epi, class Sched, bool ALIGN_EPI>
__device__ __forceinline__ void gemm_phase(LAS unsigned char* lds, const Gemm g, const Sched& S, const Epi& E, int wave_id) {
    int wid_ = wave_id; asm volatile("" : "+s"(wid_)); int lane_; asm volatile("v_mbcnt_lo_u32_b32 %0, -1, 0\n\tv_mbcnt_hi_u32_b32 %0, -1, %0" : "=v"(lane_));
    const int wid = wid_, lane = lane_, tid = wid * 64 + lane, wr = wid >> 2, wc = wid & 3, fr = lane & 15, fq = lane >> 4;
    const int K = g.K, nt = K / BK;
    unsigned voffA[2], voffB[2];
#pragma unroll
    for (int i = 0; i < 2; ++i) { int R, C; stage_rc(tid * 16 + i * 8192, R, C); const int Rb = (R & ~31) + perm32(R & 31);
        voffA[i] = (unsigned)(R * g.lda + C) * 2u; voffB[i] = (unsigned)(Rb * g.ldb + C) * 2u; }
    const size_t kstep = (size_t)(BK * 2);
    const size_t hsA = (size_t)HALF * g.lda * 2, hsB = (size_t)HALF * g.ldb * 2;
    const size_t tsA = (size_t)g.mstep * g.lda * 2, tsB = 2 * hsB;
    const unsigned ldsw = (unsigned)wid * 1024u;
    const int aoff = lds_byte(wr * 64 + fr, fq * 8), boff = lds_byte(wc * 32 + fr, fq * 8);
#define PG8_SA(b, h) (((b) * 2 + (h)) * HTB)
#define PG8_SB(b, h) ((4 + (b) * 2 + (h)) * HTB)
#define PG8_STAGE(bufoff, gbase, voff) do { _Pragma("unroll") for (int _i = 0; _i < 2; ++_i) \
        __builtin_amdgcn_global_load_lds((const GAS unsigned*)((const GAS char*)(gbase) + (voff)[_i]), (LAS unsigned*)(lds + (bufoff) + ldsw + _i * 8192), 16, 0, 0); } while (0)
#define PG8_LDA(dst, b, h) do { _Pragma("unroll") for (int m = 0; m < 4; ++m) _Pragma("unroll") for (int k = 0; k < 2; ++k) dst[m][k] = *(const LAS bf16x8*)(lds + PG8_SA(b, h) + aoff + m * 2048 + k * 1024); } while (0)
#define PG8_LDB(dst, b, h) do { _Pragma("unroll") for (int n = 0; n < 2; ++n) _Pragma("unroll") for (int k = 0; k < 2; ++k) dst[n][k] = *(const LAS bf16x8*)(lds + PG8_SB(b, h) + boff + n * 2048 + k * 1024); } while (0)
#define PG8_MMA(ai, bj, At, Bt) do { __builtin_amdgcn_s_setprio(1); _Pragma("unroll") for (int m = 0; m < 4; ++m) _Pragma("unroll") for (int n = 0; n < 2; ++n) _Pragma("unroll") for (int k = 0; k < 2; ++k) \
        acc[ai][bj][m][n] = __builtin_amdgcn_mfma_f32_16x16x32_bf16(Bt[n][k], At[m][k], acc[ai][bj][m][n], 0, 0, 0); __builtin_amdgcn_s_setprio(0); } while (0)
#define PG8_WAIT_V(n) asm volatile("s_waitcnt vmcnt(" #n ")" ::: "memory")
#define PG8_WAIT_L(n) asm volatile("s_waitcnt lgkmcnt(" #n ")" ::: "memory")
#define PG8_BAR __builtin_amdgcn_s_barrier()
#define PG8_SCHED __builtin_amdgcn_sched_barrier(0)
    Unit cur, nxt; int ui = 0;
    if (!S.next(0, cur)) return;
    f32x4 acc[2][2][4][2];
#pragma unroll
    for (int a = 0; a < 2; ++a)
#pragma unroll
        for (int b = 0; b < 2; ++b)
#pragma unroll
            for (int m = 0; m < 4; ++m)
#pragma unroll
                for (int n = 0; n < 2; ++n) acc[a][b][m][n] = (f32x4){0.f, 0.f, 0.f, 0.f};
    bf16x8 At[4][2], B0[2][2], B1[2][2];
    const GAS char* cA = (const GAS char*)(cur.kind ? g.A2 : g.A) + (size_t)cur.pm * tsA; const GAS char* cB = (const GAS char*)(cur.kind ? g.Bt2 : g.Bt) + (size_t)cur.pn * tsB;
    PG8_STAGE(PG8_SB(0, 0), cB, voffB); PG8_STAGE(PG8_SB(0, 1), cB + hsB, voffB); PG8_STAGE(PG8_SA(0, 0), cA, voffA); PG8_STAGE(PG8_SA(0, 1), cA + hsA, voffA);
    if (wr == 1) PG8_BAR;
    PG8_WAIT_V(2); PG8_BAR;
    PG8_STAGE(PG8_SB(1, 0), cB + kstep, voffB); PG8_STAGE(PG8_SA(1, 0), cA + kstep, voffA); PG8_STAGE(PG8_SB(1, 1), cB + hsB + kstep, voffB);
    PG8_WAIT_V(6); PG8_BAR;
    for (;;) {
        const bool has_next = S.next(ui + 1, nxt);
        const GAS char* nA = has_next ? (const GAS char*)(nxt.kind ? g.A2 : g.A) + (size_t)nxt.pm * tsA : cA; const GAS char* nB = has_next ? (const GAS char*)(nxt.kind ? g.Bt2 : g.Bt) + (size_t)nxt.pn * tsB : cB;
#pragma nounroll
        for (int t = 0; t < nt; t += 2) {
            const bool last = (t == nt - 2);
            const GAS char* a1 = cA + (size_t)(t + 1) * kstep;
            const GAS char* a2 = last ? nA : cA + (size_t)(t + 2) * kstep; const GAS char* b2 = last ? nB : cB + (size_t)(t + 2) * kstep;
            const GAS char* a3 = a2 + kstep; const GAS char* b3 = b2 + kstep;
            PG8_LDB(B0, 0, 0); PG8_LDB(B1, 0, 1); PG8_SCHED; PG8_LDA(At, 0, 0); PG8_STAGE(PG8_SA(1, 1), a1 + hsA, voffA);
            PG8_WAIT_V(8); PG8_WAIT_L(0); PG8_BAR; PG8_MMA(0, 0, At, B0); PG8_MMA(0, 1, At, B1); PG8_BAR; PG8_SCHED;
            PG8_LDA(At, 0, 1); PG8_STAGE(PG8_SB(0, 0), b2, voffB); PG8_STAGE(PG8_SB(0, 1), b2 + hsB, voffB); PG8_STAGE(PG8_SA(0, 0), a2, voffA);
            PG8_WAIT_V(8); PG8_WAIT_L(0); PG8_BAR; PG8_MMA(1, 0, At, B0); PG8_MMA(1, 1, At, B1); PG8_BAR; PG8_SCHED;
            PG8_LDB(B0, 1, 0); PG8_LDB(B1, 1, 1); PG8_SCHED; PG8_LDA(At, 1, 0); PG8_STAGE(PG8_SA(0, 1), a2 + hsA, voffA);
            PG8_WAIT_V(8); PG8_WAIT_L(0); PG8_BAR; PG8_MMA(0, 0, At, B0); PG8_MMA(0, 1, At, B1); PG8_BAR; PG8_SCHED;
            PG8_LDA(At, 1, 1); PG8_STAGE(PG8_SB(1, 0), b3, voffB); PG8_STAGE(PG8_SB(1, 1), b3 + hsB, voffB); PG8_STAGE(PG8_SA(1, 0), a3, voffA);
            PG8_WAIT_V(8); PG8_WAIT_L(0); PG8_BAR; PG8_MMA(1, 0, At, B0); PG8_MMA(1, 1, At, B1); PG8_BAR; PG8_SCHED;
        }
        if constexpr (ALIGN_EPI) { if (wr == 0) PG8_BAR; }
        { int ln_; asm volatile("v_mbcnt_lo_u32_b32 %0, -1, 0\n\tv_mbcnt_hi_u32_b32 %0, -1, %0" : "=v"(ln_));
          E(acc, cur, wr, wc, ln_ & 15, ln_ >> 4); }
        if (!has_next) break;
#pragma unroll
        for (int a = 0; a < 2; ++a)
#pragma unroll
            for (int b = 0; b < 2; ++b)
#pragma unroll
                for (int m = 0; m < 4; ++m)
#pragma unroll
                    for (int n = 0; n < 2; ++n) acc[a][b][m][n] = (f32x4){0.f, 0.f, 0.f, 0.f};
        cur = nxt; cA = nA; cB = nB; ++ui;
        if constexpr (ALIGN_EPI) { if (wr == 1) PG8_BAR; }
    }
    PG8_WAIT_V(0);
    if constexpr (!ALIGN_EPI) { if (wr == 0) PG8_BAR; }
    PG8_BAR;
#undef PG8_SA
#undef PG8_SB
#undef PG8_STAGE
#undef PG8_LDA
#undef PG8_LDB
#undef PG8_MMA
#undef PG8_WAIT_V
#undef PG8_WAIT_L
#undef PG8_BAR
#undef PG8_SCHED
}
}

#define XB_TMO      128
#define XB_XCNT(j)  (256  + 64 * (j))
#define XB_XSUB(j)  (1280 + 64 * (j))
#define XB_XGEN(j)  (2304 + 64 * (j))
#define XB_TOP      3328
#define XB_TOPGEN   3392
#define XCD_BAR_WORDS 3456
#define XB_SPIN_CAP (1u << 21)
__device__ __forceinline__ unsigned xb_ld(unsigned* p)              { return __hip_atomic_load(p, __ATOMIC_RELAXED, __HIP_MEMORY_SCOPE_AGENT); }
__device__ __forceinline__ unsigned xb_add(unsigned* p, unsigned v) { return __hip_atomic_fetch_add(p, v, __ATOMIC_RELAXED, __HIP_MEMORY_SCOPE_AGENT); }
__device__ __forceinline__ unsigned xb_xcc_id() { return (unsigned)__builtin_amdgcn_s_getreg((3 << 11) | 20) & 0xFu; }
#define XB_SPIN(cond, bar) do { unsigned _sp = 0; while (cond) { __builtin_amdgcn_s_sleep(1); \
    if ((++_sp & 255u) == 0u) { if (xb_ld(&(bar)[XB_TMO])) break; if (_sp > XB_SPIN_CAP) { atomicAdd(&(bar)[XB_TMO], 1u); break; } } } } while (0)
struct XcdBarrier { unsigned* bar; unsigned x; volatile LAS unsigned* st; };
__device__ __forceinline__ XcdBarrier xcd_barrier_post(unsigned* bar, volatile LAS unsigned* st) {
    XcdBarrier b; b.bar = bar; b.x = xb_xcc_id(); b.st = st;
    if (threadIdx.x == 0) (void)xb_add(&bar[XB_XCNT(b.x)], 1u);
    return b;
}
__device__ __forceinline__ void xcd_barrier_complete(unsigned* bar, unsigned x, unsigned& nloc, unsigned& nx) {
    const unsigned G = gridDim.x * gridDim.y * gridDim.z;
    unsigned sum, cnt, mine, sp = 0u;
    for (;;) {
        sum = 0u; cnt = 0u; mine = 0u;
#pragma unroll
        for (unsigned j = 0; j < 16; ++j) { const unsigned c = xb_ld(&bar[XB_XCNT(j)]); sum += c; cnt += (c > 0u) ? 1u : 0u; mine = (j == x) ? c : mine; }
        if (sum == G) break;
        __builtin_amdgcn_s_sleep(1);
        if ((++sp & 255u) == 0u) { if (xb_ld(&bar[XB_TMO])) break; if (sp > XB_SPIN_CAP) { atomicAdd(&bar[XB_TMO], 1u); break; } }
    }
    nloc = mine > 0u ? mine : 1u; nx = cnt > 0u ? cnt : 1u;
}
__device__ __forceinline__ void xcd_barrier(const XcdBarrier& b) {
    asm volatile("s_waitcnt vmcnt(0)" ::: "memory");
    __syncthreads();
    const unsigned long long bp_ = (unsigned long long)b.bar; unsigned blo_ = __builtin_amdgcn_readfirstlane((unsigned)bp_), bhi_ = __builtin_amdgcn_readfirstlane((unsigned)(bp_ >> 32));
    asm volatile("" : "+s"(blo_), "+s"(bhi_)); unsigned* bar = (unsigned*)(((unsigned long long)bhi_ << 32) | blo_);
    if (threadIdx.x == 0) {
        __builtin_amdgcn_s_waitcnt(0);
        unsigned nloc = b.st[0], nx = b.st[1];
        if (nloc == 0u) { xcd_barrier_complete(bar, b.x, nloc, nx); b.st[0] = nloc; b.st[1] = nx; }
        const unsigned old = xb_add(&bar[XB_XSUB(b.x)], 1u);
        const unsigned gen = old / nloc;
        if (old + 1u == (gen + 1u) * nloc) {
            __builtin_amdgcn_fence(__ATOMIC_RELEASE, "agent");
            asm volatile("s_waitcnt vmcnt(0)" ::: "memory");
            const unsigned og = xb_add(&bar[XB_TOP], 1u);
            const unsigned tg = og / nx;
            if (og + 1u == (tg + 1u) * nx) {
#pragma unroll
                for (unsigned j = 0; j < 16; ++j) (void)__hip_atomic_fetch_add(&bar[XB_XGEN(j)], 1u, __ATOMIC_RELAXED, __HIP_MEMORY_SCOPE_AGENT); }
        }
        XB_SPIN(xb_ld(&bar[XB_XGEN(b.x)]) == gen, bar);
        __builtin_amdgcn_fence(__ATOMIC_ACQUIRE, "agent");
        asm volatile("s_waitcnt vmcnt(0)" ::: "memory");
    }
    __syncthreads();
}

constexpr size_t MiB = 1u << 20;
constexpr size_t WS_CTL = 0, CTL_ZERO_BYTES = 1 * MiB;
constexpr size_t WS_WIN = 1 * MiB;
constexpr size_t WS_WGLU = WS_WIN + 228 * MiB;
constexpr size_t WS_WRET = WS_WGLU + 32 * MiB;
constexpr size_t WS_WRWKV = WS_WRET + 16 * MiB;
constexpr size_t WS_WO = WS_WRWKV + 16 * MiB;
constexpr size_t WS_WUP = WS_WO + 32 * MiB;
constexpr size_t WS_WDOWN = WS_WUP + 176 * MiB;
constexpr size_t WS_WLR = WS_WDOWN + 88 * MiB;
constexpr size_t WS_MST = WS_WLR + 6 * MiB;
constexpr size_t WS_MIC = WS_MST + 32 * MiB;
constexpr size_t WS_AL = WS_MIC + 48 * MiB;
constexpr size_t WS_ROPE = WS_AL + 1 * MiB;
constexpr size_t WS_XB = WS_ROPE + 8 * MiB;
constexpr size_t WS_XF = WS_XB + 32 * MiB;
constexpr size_t WS_X1F = WS_XF + 64 * MiB;
constexpr size_t WS_X1B = WS_X1F + 64 * MiB;
constexpr size_t WS_U2 = WS_X1B + 33 * MiB;
constexpr size_t WS_RQ = WS_U2 + 24 * MiB;
constexpr size_t WS_RK = WS_RQ + 16 * MiB;
constexpr size_t WS_RKT = WS_RK + 16 * MiB;
constexpr size_t WS_RVT = WS_RKT + 16 * MiB;
constexpr size_t WS_RG = WS_RVT + 16 * MiB;
constexpr size_t WS_ZR = WS_RG + 16 * MiB;
constexpr size_t WS_GATES = WS_ZR + 52 * MiB;
constexpr size_t WS_SLOC = WS_GATES + 96 * MiB;
constexpr size_t WS_Z = WS_SLOC + 16 * MiB;
constexpr size_t WS_KVT = WS_Z + 16 * MiB;
constexpr size_t WS_PREVT = WS_KVT + 32 * MiB;
constexpr size_t WS_ORET = WS_PREVT + 16 * MiB;
constexpr size_t WS_ALR = WS_ORET + 16 * MiB;
constexpr size_t WS_DEC = WS_ALR + 4 * MiB;
constexpr size_t WS_AA = WS_DEC + 32 * MiB;
constexpr size_t WS_GG = WS_AA + 32 * MiB;
constexpr size_t WS_RW = WS_GG + 32 * MiB;
constexpr size_t WS_BONUS = WS_RW + 192 * MiB;
constexpr size_t WS_ORWKV = WS_BONUS + 1 * MiB;
constexpr size_t WS_MERGED = WS_ORWKV + 16 * MiB;
constexpr size_t WS_MERGEDB = WS_MERGED + 64 * MiB;
constexpr size_t WS_V1 = WS_MERGEDB + 32 * MiB;
constexpr size_t WS_AF = WS_V1 + 64 * MiB;
constexpr size_t WS_BF = WS_AF + 16 * MiB;
constexpr size_t WS_RT = WS_BF + 16 * MiB;
constexpr size_t WS_ARBT = WS_RT + 16 * MiB;
constexpr size_t WS_PL = WS_ARBT + 16 * MiB;
constexpr size_t WS_STATS2 = WS_PL + 2 * MiB;
constexpr size_t WS_STATS1 = WS_STATS2 + 1 * MiB;
constexpr size_t WS_C12 = WS_STATS1 + 1 * MiB;
constexpr size_t WS_PART = WS_C12 + 1 * MiB;
constexpr size_t WS_END = WS_PART + 28 * MiB;
constexpr size_t WS_VK2F = WS_V1;
constexpr size_t WS_S0B = WS_V1 + 32 * MiB;
constexpr size_t WS_XTB = WS_V1 + 48 * MiB;
constexpr size_t WS_Y0 = WS_RW + 160 * MiB;
constexpr size_t WS_M1 = WS_RW + 64 * MiB;
constexpr size_t WS_H = WS_RW;
constexpr size_t WS_HACT = WS_GATES;
constexpr int CW_BAR = 4096;

constexpr int RING_BYTES = 139264;
constexpr int LDSCTL_OFF = RING_BYTES, MISC_OFF = LDSCTL_OFF + 320;
constexpr int LDS_BASE = 1024;
constexpr int LDS_BYTES = 147456 + LDS_BASE;
constexpr int NWAVES = 8;

struct Ctx {
    LAS unsigned char* lds;
    int tid, lane, wave, vcu, G, gw, NGW, bx;
};
__device__ __forceinline__ int lane_id_now() { int l; asm volatile("v_mbcnt_lo_u32_b32 %0, -1, 0\n\tv_mbcnt_hi_u32_b32 %0, -1, %0" : "=v"(l)); return l; }
__device__ __forceinline__ Ctx fresh(const Ctx& c0) {
    Ctx c = c0; asm volatile("" : "+s"(c.wave), "+s"(c.vcu), "+s"(c.gw), "+s"(c.bx)); c.lane = lane_id_now(); c.tid = c.wave * 64 + c.lane; return c;
}
constexpr int PTAB_OFF = LDSCTL_OFF + 512;
__device__ __forceinline__ unsigned long long ptab(const Ctx& c, int k) {
    unsigned pb_ = LDS_BASE + PTAB_OFF; asm volatile("" : "+v"(pb_));
    const LAS unsigned* p = (const LAS unsigned*)(pb_ + 8 * k);
    const unsigned lo = __builtin_amdgcn_readfirstlane(p[0]), hi = __builtin_amdgcn_readfirstlane(p[1]);
    return ((unsigned long long)hi << 32) | lo;
}
__device__ __forceinline__ const GAS float* inp(const Ctx& c, int k) { return (const GAS float*)ptab(c, k); }
__device__ __forceinline__ GAS unsigned char* wsp(const Ctx& c) { return (GAS unsigned char*)ptab(c, 35); }
__device__ __forceinline__ GAS float* outp(const Ctx& c) { return (GAS float*)ptab(c, 36); }

constexpr int C12_STRIDE = 2 * NIN + 2 * 11264;
constexpr float ST_SCALE = 1048576.f, ST_INV = 1.f / 1048576.f;
typedef long long i64x2 __attribute__((ext_vector_type(2)));
__device__ __forceinline__ void row_stats(const GAS float* ST, int t, float& mu, float& rs) {
    const i64x2 a = *(const GAS i64x2*)((const GAS long long*)ST + (size_t)t * 2);
    const float s1 = (float)a.x * ST_INV, s2 = (float)a.y * ST_INV;
    mu = s1 * (1.f / D); rs = rsq(s2 * (1.f / D) - mu * mu + LN_EPS);
}
using pg8::Unit;
#define EPI_LOOP_ROWS for (int ai = 0; ai < 2; ++ai) _Pragma("unroll") for (int m = 0; m < 4; ++m)

struct EpiProj {
    GAS bf16 *U2, *RQ, *RK, *RG, *ZR, *GATES; const GAS float *ropeC, *ropeS, *ST, *C1, *C2;
    __device__ __forceinline__ void operator()(f32x4 (&acc)[2][2][4][2], const Unit& u, int wr, int wc, int fr, int fq) const {
        const int pn = u.pn, rowl = u.pm * 256 + wr * 64 + fr, cl = wc * 32 + 8 * fq;
        { f32x4 c1v[2][2], c2v[2][2];
#pragma unroll
          for (int bj = 0; bj < 2; ++bj)
#pragma unroll
              for (int n = 0; n < 2; ++n) { const int col = pn * 256 + bj * 128 + cl + 4 * n; c1v[bj][n] = *(const GAS f32x4*)(C1 + col); c2v[bj][n] = *(const GAS f32x4*)(C2 + col); }
          i64x2 st[2][4];
#pragma unroll
          EPI_LOOP_ROWS st[ai][m] = *(const GAS i64x2*)((const GAS long long*)ST + (size_t)(rowl + ai * 128 + m * 16) * 2);
#pragma unroll
          EPI_LOOP_ROWS { const float q1 = (float)st[ai][m].x * ST_INV, q2 = (float)st[ai][m].y * ST_INV, mu = q1 * (1.f / D), rs = rsq(q2 * (1.f / D) - mu * mu + LN_EPS);
#pragma unroll
              for (int bj = 0; bj < 2; ++bj)
#pragma unroll
                  for (int n = 0; n < 2; ++n) acc[ai][bj][m][n] = (acc[ai][bj][m][n] - c1v[bj][n] * mu) * rs + c2v[bj][n]; } }
        if (pn < 4) {
#pragma unroll
            EPI_LOOP_ROWS { const int t = rowl + ai * 128 + m * 16, n = t >> 4, tt = t & 15;
#pragma unroll
                for (int bj = 0; bj < 2; ++bj) { const int c = pn * 256 + bj * 128 + cl, g = c >> 4, half = (c >> 3) & 1;
                    *(GAS u32x4*)(U2 + ((size_t)(g * 512 + n) * 384 + tt * 16 + half * 8)) = pack8(acc[ai][bj][m][0], acc[ai][bj][m][1]); } }
        } else if (pn < 12) {
            const bool isk = pn >= 8; const int tb = pn - (isk ? 8 : 4), h = 2 * tb + (wc >> 1), i0 = 32 * (wc & 1) + 8 * fq;
            const float l2g = l2gamma(h);
            GAS bf16* dst = isk ? RK : RQ;
#pragma unroll
            for (int ai = 0; ai < 2; ++ai) { f32x4 rp[4][4];
#pragma unroll
              for (int m = 0; m < 4; ++m) { const int t = rowl + ai * 128 + m * 16; rp[m][0] = *(const GAS f32x4*)(ropeC + (size_t)t * 64 + i0); rp[m][1] = *(const GAS f32x4*)(ropeC + (size_t)t * 64 + i0 + 4);
                  rp[m][2] = *(const GAS f32x4*)(ropeS + (size_t)t * 64 + i0); rp[m][3] = *(const GAS f32x4*)(ropeS + (size_t)t * 64 + i0 + 4); }
#pragma unroll
              for (int m = 0; m < 4; ++m) { const int t = rowl + ai * 128 + m * 16; const float tl = (float)(t & 127);
                const float sc = isk ? ex2(-tl * l2g) * 0.08838834764831845f : ex2(tl * l2g);
                const f32x4 c0 = rp[m][0], c1 = rp[m][1], s0 = rp[m][2], s1 = rp[m][3];
                const f32x4 a0 = acc[ai][0][m][0], a1 = acc[ai][0][m][1], b0 = acc[ai][1][m][0], b1 = acc[ai][1][m][1];
                const f32x4 o10 = (a0 * c0 - b0 * s0) * sc, o11 = (a1 * c1 - b1 * s1) * sc, o20 = (b0 * c0 + a0 * s0) * sc, o21 = (b1 * c1 + a1 * s1) * sc;
                GAS bf16* p = dst + (size_t)t * 1024 + 128 * h + i0;
                *(GAS u32x4*)p = pack8(o10, o11); *(GAS u32x4*)(p + 64) = pack8(o20, o21); } }
        } else if (pn < 20) {
#pragma unroll
            EPI_LOOP_ROWS { const int t = rowl + ai * 128 + m * 16;
#pragma unroll
                for (int bj = 0; bj < 2; ++bj) { const f32x4 x0 = acc[ai][bj][m][0], x1 = acc[ai][bj][m][1];
                    *(GAS u32x4*)(RG + (size_t)t * 1024 + (pn - 16) * 256 + bj * 128 + cl) = pack8(x0 * sigm4(x0), x1 * sigm4(x1)); } }
        } else if (pn < 33) {
#pragma unroll
            EPI_LOOP_ROWS { const int t = rowl + ai * 128 + m * 16;
#pragma unroll
                for (int bj = 0; bj < 2; ++bj) *(GAS u32x4*)(ZR + (size_t)t * RWKV_IN + (pn - 20) * 256 + bj * 128 + cl) = pack8(acc[ai][bj][m][0], acc[ai][bj][m][1]); }
        } else {
#pragma unroll
            EPI_LOOP_ROWS { const int t = rowl + ai * 128 + m * 16;
#pragma unroll
                for (int bj = 0; bj < 2; ++bj) *(GAS u32x4*)(GATES + (size_t)t * 6144 + (pn - 33) * 256 + bj * 128 + cl) = pack8(sigm4(acc[ai][bj][m][0]), sigm4(acc[ai][bj][m][1])); }
        }
    }
};
struct EpiProjT {
    GAS bf16 *RKT, *RVT; const GAS float *ropeCT, *ropeST, *ST, *C1, *C2;
    __device__ __forceinline__ void operator()(f32x4 (&acc)[2][2][4][2], const Unit& u, int wr, int wc, int fr, int fq) const {
        const int pm = u.pm, h = 2 * pm + wr; const float l2g = l2gamma(h & 7);
#pragma unroll
        for (int bj = 0; bj < 2; ++bj) { const unsigned t0 = u.pn * 256 + bj * 128 + wc * 32 + 8 * fq; f32x4 mu0, mu1, rs0, rs1;
#pragma unroll
            for (int j = 0; j < 4; ++j) { float a, b; row_stats(ST, (int)t0 + j, a, b); mu0[j] = a; rs0[j] = b; row_stats(ST, (int)t0 + 4 + j, a, b); mu1[j] = a; rs1[j] = b; }
            f32x4 sc0, sc1; const float tl0 = (float)(t0 & 127u);
#pragma unroll
            for (int j = 0; j < 4; ++j) { sc0[j] = ex2(-(tl0 + (float)j) * l2g) * 0.08838834764831845f; sc1[j] = ex2(-(tl0 + (float)(j + 4)) * l2g) * 0.08838834764831845f; }
#pragma unroll
            for (int m = 0; m < 4; ++m) { const unsigned f0 = pm * 256 + wr * 64 + m * 16 + fr;
                const float c1a = C1[f0], c2a = C2[f0], c1b = C1[f0 + 128], c2b = C2[f0 + 128];
                const f32x4 a0 = (acc[0][bj][m][0] - mu0 * c1a) * rs0 + c2a, a1 = (acc[0][bj][m][1] - mu1 * c1a) * rs1 + c2a, b0 = (acc[1][bj][m][0] - mu0 * c1b) * rs0 + c2b, b1 = (acc[1][bj][m][1] - mu1 * c1b) * rs1 + c2b;
                if (pm < 4) { const unsigned i = 16 * m + fr, ro = i * (unsigned)T + t0;
                    const f32x4 c0 = *(const GAS f32x4*)(ropeCT + ro), c1 = *(const GAS f32x4*)(ropeCT + ro + 4), s0 = *(const GAS f32x4*)(ropeST + ro), s1 = *(const GAS f32x4*)(ropeST + ro + 4);
                    const unsigned o = (128u * h + i) * (unsigned)T + t0;
                    *(GAS u32x4*)(RKT + o) = pack8((a0 * c0 - b0 * s0) * sc0, (a1 * c1 - b1 * s1) * sc1); *(GAS u32x4*)(RKT + o + 64u * T) = pack8((b0 * c0 + a0 * s0) * sc0, (b1 * c1 + a1 * s1) * sc1); }
                else { const unsigned o = (f0 - 1024u) * (unsigned)T + t0; *(GAS u32x4*)(RVT + o) = pack8(a0, a1); *(GAS u32x4*)(RVT + o + 128u * T) = pack8(b0, b1); } }
            __builtin_amdgcn_sched_barrier(0); }
    }
};
struct EpiProjAll {
    EpiProj a; EpiProjT b;
    __device__ __forceinline__ void operator()(f32x4 (&acc)[2][2][4][2], const Unit& u, int wr, int wc, int fr, int fq) const {
        if (u.kind == 0) { asm volatile("" : "+v"(fr), "+v"(fq)); a(acc, u, wr, wc, fr, fq); } else { asm volatile("" : "+v"(fr), "+v"(fq)); b(acc, u, wr, wc, fr, fq); } }
};
struct EpiLR {
    GAS float* DEC; const GAS float *w0, *a0;
    __device__ __forceinline__ void operator()(const f32x4 (&acc)[2][2][4][2], const Unit& u, int wr, int wc, int fr, int fq) const {
        const int part = u.pn >> 2, rowl = u.pm * 256 + wr * 64 + fr;
        GAS float* dst = DEC + (size_t)part * ((size_t)T * 1024);
#pragma unroll
        for (int bj = 0; bj < 2; ++bj) { const int c = (u.pn & 3) * 256 + bj * 128 + wc * 32 + 8 * fq;
            f32x4 bv0 = (f32x4){0.f, 0.f, 0.f, 0.f}, bv1 = bv0;
            if (part == 0) { bv0 = *(const GAS f32x4*)(w0 + c); bv1 = *(const GAS f32x4*)(w0 + c + 4); }
            if (part == 1) { bv0 = *(const GAS f32x4*)(a0 + c); bv1 = *(const GAS f32x4*)(a0 + c + 4); }
#pragma unroll
            EPI_LOOP_ROWS { const int t = rowl + ai * 128 + m * 16; f32x4 v0 = acc[ai][bj][m][0] + bv0, v1 = acc[ai][bj][m][1] + bv1;
                if (part == 0) {
#pragma unroll
                    for (int j = 0; j < 4; ++j) { v0[j] = -0.6065306597126334f * sigm(v0[j]); v1[j] = -0.6065306597126334f * sigm(v1[j]); } }
                if (part == 1) { v0 = sigm4(v0); v1 = sigm4(v1); }
                if (part == 0) { *(GAS f32x4*)(dst + (size_t)t * 1024 + c) = v0; *(GAS f32x4*)(dst + (size_t)t * 1024 + c + 4) = v1; }
                else *(GAS u32x4*)((GAS bf16*)dst + (size_t)t * 1024 + c) = pack8(v0, v1); } }
    }
};
struct EpiS1 {
    GAS float* SLOC;
    __device__ __forceinline__ void operator()(const f32x4 (&acc)[2][2][4][2], const Unit& u, int wr, int wc, int fr, int fq) const {
        const int g = u.pn, nb = (u.pm & 1) * 256 + wr * 64 + fr, c = wc * 32 + 8 * fq;
#pragma unroll
        EPI_LOOP_ROWS { const int n = nb + ai * 128 + m * 16; GAS float* p = SLOC + (size_t)(g * 512 + n) * 128 + c;
            *(GAS f32x4*)p = acc[ai][0][m][0]; *(GAS f32x4*)(p + 4) = acc[ai][0][m][1]; }
    }
};
struct EpiS3 {
    const GAS bf16* U2; GAS bf16* Z; const GAS float* dsk;
    __device__ __forceinline__ void operator()(const f32x4 (&acc)[2][2][4][2], const Unit& u, int wr, int wc, int fr, int fq) const {
        const int g = u.pn, nb = (u.pm & 1) * 256 + wr * 64 + fr;
#pragma unroll
        for (int bj = 0; bj < 2; ++bj) { const int jj = bj * 128 + wc * 32 + 8 * fq, tt = jj >> 4, c0 = jj & 15, ch = 16 * g + c0;
            const f32x4 d0 = *(const GAS f32x4*)(dsk + ch), d1 = *(const GAS f32x4*)(dsk + ch + 4);
            u32x4 uv[2][4];
#pragma unroll
            EPI_LOOP_ROWS uv[ai][m] = *(const GAS u32x4*)(U2 + (size_t)(g * 512 + nb + ai * 128 + m * 16) * 384 + jj);
#pragma unroll
            EPI_LOOP_ROWS { const int n = nb + ai * 128 + m * 16;
                f32x4 u0, u1; unpack8(uv[ai][m], u0, u1);
                f32x4 y0 = acc[ai][bj][m][0] + d0 * u0, y1 = acc[ai][bj][m][1] + d1 * u1;
#pragma unroll
                for (int j = 0; j < 4; ++j) { y0[j] = gelu_tanh(y0[j]); y1[j] = gelu_tanh(y1[j]); }
                *(GAS u32x4*)(Z + (size_t)(16 * n + tt) * 1024 + ch) = pack8(y0, y1); } }
    }
};
template <int MODE> struct EpiMerge {
    GAS bf16* M0; GAS bf16* M1; GAS bf16* MERGEDB; const GAS bf16* GATES;
    __device__ __forceinline__ void operator()(const f32x4 (&acc)[2][2][4][2], const Unit& u, int wr, int wc, int fr, int fq) const {
        const int rowl = u.pm * 256 + wr * 64 + fr;
        if (MODE == 1) {
            const int c = u.pn * 128 + wc * 32 + 8 * fq; u32x4 gt[2][4];
#pragma unroll
            EPI_LOOP_ROWS gt[ai][m] = *(const GAS u32x4*)(GATES + (size_t)(rowl + ai * 128 + m * 16) * 6144 + c);
#pragma unroll
            EPI_LOOP_ROWS { const int t = rowl + ai * 128 + m * 16; f32x4 g0, g1; unpack8(gt[ai][m], g0, g1);
                *(GAS u32x4*)(M0 + (size_t)t * 2048 + c) = pack8(g0 * acc[ai][0][m][0] * sigm4(acc[ai][1][m][0]), g1 * acc[ai][0][m][1] * sigm4(acc[ai][1][m][1])); }
        } else if (MODE == 0) {
            u32x4 gt[2][4][2];
#pragma unroll
            EPI_LOOP_ROWS {
#pragma unroll
                for (int bj = 0; bj < 2; ++bj) gt[ai][m][bj] = *(const GAS u32x4*)(GATES + (size_t)(rowl + ai * 128 + m * 16) * 6144 + 2048 + u.pn * 256 + bj * 128 + wc * 32 + 8 * fq); }
#pragma unroll
            EPI_LOOP_ROWS { const int t = rowl + ai * 128 + m * 16;
#pragma unroll
                for (int bj = 0; bj < 2; ++bj) { const int c = u.pn * 256 + bj * 128 + wc * 32 + 8 * fq; const size_t o = (size_t)t * 2048 + c;
                    f32x4 g0, g1; unpack8(gt[ai][m][bj], g0, g1);
                    *(GAS u32x4*)(M1 + o) = pack8(g0 * acc[ai][bj][m][0], g1 * acc[ai][bj][m][1]); } }
        } else {
#pragma unroll
            for (int ai = 0; ai < 2; ++ai)
#pragma unroll
            for (int mp = 0; mp < 2; ++mp) { u32x4 gt[2][2], ma[2][2], mb[2][2];
#pragma unroll
                for (int mi = 0; mi < 2; ++mi)
#pragma unroll
                    for (int bj = 0; bj < 2; ++bj) { const int t = rowl + ai * 128 + (2 * mp + mi) * 16, c = u.pn * 256 + bj * 128 + wc * 32 + 8 * fq; const size_t o = (size_t)t * 2048 + c;
                        gt[mi][bj] = *(const GAS u32x4*)(GATES + (size_t)t * 6144 + 4096 + c); ma[mi][bj] = *(const GAS u32x4*)(M0 + o); mb[mi][bj] = *(const GAS u32x4*)(M1 + o); }
#pragma unroll
                for (int mi = 0; mi < 2; ++mi)
#pragma unroll
                    for (int bj = 0; bj < 2; ++bj) { const int m = 2 * mp + mi, t = rowl + ai * 128 + m * 16, c = u.pn * 256 + bj * 128 + wc * 32 + 8 * fq; const size_t o = (size_t)t * 2048 + c;
                        f32x4 g0, g1, a0, a1, b0, b1; unpack8(gt[mi][bj], g0, g1); unpack8(ma[mi][bj], a0, a1); unpack8(mb[mi][bj], b0, b1);
                        *(GAS u32x4*)(MERGEDB + o) = pack8(a0 + b0 + g0 * acc[ai][bj][m][0], a1 + b1 + g1 * acc[ai][bj][m][1]); } }
        }
    }
};
struct EpiMerge01 {
    EpiMerge<0> a; EpiMerge<1> b;
    __device__ __forceinline__ void operator()(const f32x4 (&acc)[2][2][4][2], const Unit& u, int wr, int wc, int fr, int fq) const {
        if (u.kind == 0) { asm volatile("" : "+v"(fr), "+v"(fq)); a(acc, u, wr, wc, fr, fq); } else { asm volatile("" : "+v"(fr), "+v"(fq)); b(acc, u, wr, wc, fr, fq); } }
};
struct EpiResidStats {
    const GAS float* Xraw; const GAS bf16* Hs; const GAS bf16* Ls; const GAS float* STs; const GAS float* gs; const GAS float* bs; GAS bf16* VB; GAS bf16* VL; GAS float* STo;
    __device__ __forceinline__ void operator()(f32x4 (&acc)[2][2][4][2], const Unit& u, int wr, int wc, int fr, int fq) const {
        const int rowl = u.pm * 256 + wr * 64 + fr;
        f32x4 gv[2][2], bv[2][2];
#pragma unroll
        for (int bj = 0; bj < 2; ++bj)
#pragma unroll
            for (int n = 0; n < 2; ++n) { const int col = u.pn * 256 + bj * 128 + wc * 32 + 8 * fq + 4 * n;
                gv[bj][n] = STs ? *(const GAS f32x4*)(gs + col) : (f32x4){1.f, 1.f, 1.f, 1.f}; bv[bj][n] = STs ? *(const GAS f32x4*)(bs + col) : (f32x4){0.f, 0.f, 0.f, 0.f}; }
#pragma unroll
        for (int ai = 0; ai < 2; ++ai)
#pragma unroll
        for (int mp = 0; mp < 2; ++mp) {
            i64x2 st[2]; u32x4 xa[2][2], xb[2][2];
#pragma unroll
            for (int mi = 0; mi < 2; ++mi) { const int m = 2 * mp + mi, t = rowl + ai * 128 + m * 16;
                if (STs) st[mi] = *(const GAS i64x2*)((const GAS long long*)STs + (size_t)t * 2);
#pragma unroll
                for (int bj = 0; bj < 2; ++bj) { const size_t o = (size_t)t * 2048 + u.pn * 256 + bj * 128 + wc * 32 + 8 * fq;
                    if (STs) { xa[mi][bj] = *(const GAS u32x4*)(Hs + o); xb[mi][bj] = RESID_LO ? *(const GAS u32x4*)(Ls + o) : (u32x4){0u, 0u, 0u, 0u}; }
                    else { xa[mi][bj] = *(const GAS u32x4*)(Xraw + o); xb[mi][bj] = *(const GAS u32x4*)(Xraw + o + 4); } } }
#pragma unroll
            for (int mi = 0; mi < 2; ++mi) { const int m = 2 * mp + mi, t = rowl + ai * 128 + m * 16; float mu = 0.f, rs = 1.f;
                if (STs) { const float q1 = (float)st[mi].x * ST_INV, q2 = (float)st[mi].y * ST_INV; mu = q1 * (1.f / D); rs = rsq(q2 * (1.f / D) - mu * mu + LN_EPS); }
                float s1 = 0.f, s2 = 0.f;
#pragma unroll
                for (int bj = 0; bj < 2; ++bj) { const size_t o = (size_t)t * 2048 + u.pn * 256 + bj * 128 + wc * 32 + 8 * fq;
                    f32x4 x0, x1;
                    if (STs) { f32x4 l0, l1; unpack8(xa[mi][bj], x0, x1); unpack8(xb[mi][bj], l0, l1); x0 += l0; x1 += l1; }
                    else { x0 = __builtin_bit_cast(f32x4, xa[mi][bj]); x1 = __builtin_bit_cast(f32x4, xb[mi][bj]); }
                    const f32x4 v0 = ((x0 - mu) * rs * gv[bj][0] + bv[bj][0]) * DN_ALPHA + acc[ai][bj][m][0], v1 = ((x1 - mu) * rs * gv[bj][1] + bv[bj][1]) * DN_ALPHA + acc[ai][bj][m][1];
                    const u32x4 hi = pack8(v0, v1); f32x4 h0, h1; unpack8(hi, h0, h1);
                    *(GAS u32x4*)(VB + o) = hi; if (RESID_LO) *(GAS u32x4*)(VL + o) = pack8(v0 - h0, v1 - h1);
                    const f32x4 w0 = RESID_LO ? v0 : h0, w1 = RESID_LO ? v1 : h1;
                    s1 += ((w0[0] + w0[1]) + (w0[2] + w0[3])) + ((w1[0] + w1[1]) + (w1[2] + w1[3]));
                    s2 += ((w0[0] * w0[0] + w0[1] * w0[1]) + (w0[2] * w0[2] + w0[3] * w0[3])) + ((w1[0] * w1[0] + w1[1] * w1[1]) + (w1[2] * w1[2] + w1[3] * w1[3])); }
                s1 += __shfl_xor(s1, 16); s1 += __shfl_xor(s1, 32); s2 += __shfl_xor(s2, 16); s2 += __shfl_xor(s2, 32);
                if (fq == 0) { GAS unsigned long long* so = (GAS unsigned long long*)STo + (size_t)t * 2;
                    __hip_atomic_fetch_add(so, (unsigned long long)(long long)(s1 * ST_SCALE), __ATOMIC_RELAXED, __HIP_MEMORY_SCOPE_AGENT); __hip_atomic_fetch_add(so + 1, (unsigned long long)(long long)(s2 * ST_SCALE), __ATOMIC_RELAXED, __HIP_MEMORY_SCOPE_AGENT); } } }
    }
};
__device__ __forceinline__ float dpp_ror1(float x) { return __builtin_bit_cast(float, __builtin_amdgcn_mov_dpp(__builtin_bit_cast(int, x), 0x121, 0xf, 0xf, true)); }
__device__ __forceinline__ float dpp_ror2(float x) { return __builtin_bit_cast(float, __builtin_amdgcn_mov_dpp(__builtin_bit_cast(int, x), 0x122, 0xf, 0xf, true)); }
struct EpiUpConv {
    GAS bf16* HA; const GAS float *ST, *C1, *C2, *wcv; LAS unsigned char* lds;
    __device__ __forceinline__ void operator()(f32x4 (&acc)[2][2][4][2], const Unit& u, int wr, int wc, int fr, int fq) const {
        const int tbase = 254 * u.pm - 2 + wr * 64 + fr, cl = wc * 32 + 8 * fq;
        { f32x4 c1v[2][2], c2v[2][2];
#pragma unroll
          for (int bj = 0; bj < 2; ++bj)
#pragma unroll
              for (int n = 0; n < 2; ++n) { const int col = u.pn * 256 + bj * 128 + cl + 4 * n; c1v[bj][n] = *(const GAS f32x4*)(C1 + col); c2v[bj][n] = *(const GAS f32x4*)(C2 + col); }
          i64x2 st[2][4];
#pragma unroll
          EPI_LOOP_ROWS { const int t = tbase + ai * 128 + m * 16, tc = t < 0 ? 0 : (t > T - 1 ? T - 1 : t); st[ai][m] = *(const GAS i64x2*)((const GAS long long*)ST + (size_t)tc * 2); }
#pragma unroll
          EPI_LOOP_ROWS { const int t = tbase + ai * 128 + m * 16; const bool ok = (t >= 0) && (t < T);
              const float q1 = (float)st[ai][m].x * ST_INV, q2 = (float)st[ai][m].y * ST_INV, mu = q1 * (1.f / D), rs = rsq(q2 * (1.f / D) - mu * mu + LN_EPS);
#pragma unroll
              for (int bj = 0; bj < 2; ++bj)
#pragma unroll
                  for (int n = 0; n < 2; ++n) { const f32x4 x = (acc[ai][bj][m][n] - c1v[bj][n] * mu) * rs + c2v[bj][n]; acc[ai][bj][m][n] = ok ? x : (f32x4){0.f, 0.f, 0.f, 0.f}; }
              __builtin_amdgcn_sched_barrier(0); } }
        const GAS float* wa = wcv + 128 * u.pn + cl;
        f32x4 w0a[2][2], w1a[2][2], w2a[2][2];
#pragma unroll
        for (int bj = 0; bj < 2; ++bj)
#pragma unroll
            for (int n = 0; n < 2; ++n) { const GAS float* p = wa + bj * 5632 + 4 * n; w0a[bj][n] = *(const GAS f32x4*)p; w1a[bj][n] = *(const GAS f32x4*)(p + 11264); w2a[bj][n] = *(const GAS f32x4*)(p + 2 * 11264); }
        LAS f32x4* HALO = (LAS f32x4*)(lds + 131072);
        if (fr >= 14) {
#pragma unroll
            for (int ai = 0; ai < 2; ++ai)
#pragma unroll
                for (int bj = 0; bj < 2; ++bj)
#pragma unroll
                    for (int n = 0; n < 2; ++n) HALO[(((((ai * 2 + wr) * 4 + wc) * 2 + bj) * 2 + n) * 4 + fq) * 2 + (fr - 14)] = acc[ai][bj][3][n]; }
        asm volatile("s_waitcnt lgkmcnt(0)" ::: "memory"); __builtin_amdgcn_s_barrier(); asm volatile("" ::: "memory");
#pragma unroll
        for (int bj = 0; bj < 2; ++bj) { f32x4 w0v[2], w1v[2], w2v[2];
#pragma unroll
            for (int n = 0; n < 2; ++n) { w0v[n] = w0a[bj][n]; w1v[n] = w1a[bj][n]; w2v[n] = w2a[bj][n]; }
#pragma unroll
            for (int ai = 0; ai < 2; ++ai) { const int sai = wr ? ai : (ai > 0 ? ai - 1 : 0), swr = wr ^ 1;
#pragma unroll
                for (int n = 0; n < 2; ++n) {
                    const int hb = (((((sai * 2 + swr) * 4 + wc) * 2 + bj) * 2 + n) * 4 + fq) * 2; const f32x4 h14 = HALO[hb], h15 = HALO[hb + 1];
                    asm volatile("" : "+v"(acc[ai][bj][0][n]), "+v"(acc[ai][bj][1][n]), "+v"(acc[ai][bj][2][n]), "+v"(acc[ai][bj][3][n]));
                    f32x4 c1r, c2r;
#pragma unroll
                    for (int e = 0; e < 4; ++e) { c1r[e] = dpp_ror1(acc[ai][bj][3][n][e]); c2r[e] = dpp_ror2(acc[ai][bj][3][n][e]); }
#pragma unroll
                    for (int m = 3; m >= 0; --m) { f32x4 q1 = h15, q2 = (fr == 0) ? h14 : h15;
                        if (m > 0) {
#pragma unroll
                            for (int e = 0; e < 4; ++e) { q1[e] = dpp_ror1(acc[ai][bj][m > 0 ? m - 1 : 0][n][e]); q2[e] = dpp_ror2(acc[ai][bj][m > 0 ? m - 1 : 0][n][e]); } }
                        const f32x4 p1 = (fr >= 1) ? c1r : q1, p2 = (fr >= 2) ? c2r : q2;
                        acc[ai][bj][m][n] = w0v[n] * p2 + w1v[n] * p1 + w2v[n] * acc[ai][bj][m][n];
                        c1r = q1; c2r = q2; }
                    asm volatile("" : "+v"(acc[ai][bj][0][n]), "+v"(acc[ai][bj][1][n]), "+v"(acc[ai][bj][2][n]), "+v"(acc[ai][bj][3][n]));
                    __builtin_amdgcn_sched_barrier(0); } } }
#pragma unroll
        EPI_LOOP_ROWS { const int t = tbase + ai * 128 + m * 16; const bool halo = (ai == 0) && (wr == 0) && (m == 0) && (fr < 2);
            if (!halo && t < T) { const f32x4 a0 = acc[ai][0][m][0], a1 = acc[ai][0][m][1];
                *(GAS u32x4*)(HA + (size_t)t * DFF + 128 * u.pn + cl) = pack8(a0 * sigm4(a0) * acc[ai][1][m][0], a1 * sigm4(a1) * acc[ai][1][m][1]); } }
    }
};
struct ProjOrder : pg8::StaticOrder {
    __device__ bool next(int i, Unit& u) const { if (!pg8::StaticOrder::next(i, u)) return false; if (u.pn >= 12) u.pn += 4; return true; }
};
struct GroupOrder {
    int G, c;
    __device__ bool next(int i, Unit& u) const { const int L = i * G + c; if (L >= 128) return false; u.pm = L; u.pn = L >> 1; u.kind = 0; return true; }
};
template <class S0, class S1> struct DualOrder {
    S0 a; S1 b; int n0, G, c;
    __device__ bool next(int i, Unit& u) const { const int L = i * G + c; if (L < n0) return a.next(L, u); if (!b.next(L - n0, u)) return false; u.kind = 1; return true; }
};

#ifndef PROBE_ID
#define PROBE_ID (-1)
#define PROBE_N 1
#endif
#define PRB(id) _Pragma("nounroll") for (int r_ = 0; r_ < ((id) == PROBE_ID ? PROBE_N : 1); ++r_)
__device__ __forceinline__ float wave_sum(float v) {
#pragma unroll
    for (int o = 1; o < 64; o <<= 1) v += __shfl_xor(v, o);
    return v;
}
#define LDS_WAIT() asm volatile("s_waitcnt lgkmcnt(0)" ::: "memory")

#ifndef DEFER_CONV
#define DEFER_CONV 1
#endif
#ifndef CONV_B1
#define CONV_B1 9500
#define CONV_B2 19000
#define CONV_B3 27000
#endif
__device__ __forceinline__ int dst_row(int mode, int n) {
    if (mode == 1) { if (n < 1024 || n >= 3072) return n; const int nl = n & 255, hh = nl >> 7, d = nl & 127; return (n - nl) + hh * 64 + (d & 63) + (d >> 6) * 128; }
    if (mode >= 2) { const int hn = (mode == 2) ? 2048 : 5632; return n < hn ? ((n >> 7) * 256 + (n & 127)) : (((n - hn) >> 7) * 256 + 128 + ((n - hn) & 127)); }
    return n;
}
constexpr int CONV_E0 = 32 * 456, CONV_E1 = CONV_E0 + 16 * 128, CONV_E2 = CONV_E1 + 16 * 64, CONV_E3 = CONV_E2 + 16 * 64, CONV_E4 = CONV_E3 + 32 * 64, CONV_E5 = CONV_E4 + 32 * 352, CONV_TOT = CONV_E5 + 88 * 64;
struct ConvItem { int m, K, N, kb, nb; };
__device__ __forceinline__ ConvItem conv_decode(int it) { ConvItem d; int r;
    if (it < CONV_E0) { d.m = 0; d.K = 2048; d.N = NIN; r = it; d.kb = r / 456; d.nb = r - d.kb * 456; }
    else if (it < CONV_E1) { d.m = 1; d.K = 1024; d.N = 4096; r = it - CONV_E0; d.kb = r >> 7; d.nb = r & 127; }
    else if (it < CONV_E2) { d.m = 2; d.K = 1024; d.N = 2048; r = it - CONV_E1; d.kb = r >> 6; d.nb = r & 63; }
    else if (it < CONV_E3) { d.m = 3; d.K = 1024; d.N = 2048; r = it - CONV_E2; d.kb = r >> 6; d.nb = r & 63; }
    else if (it < CONV_E4) { d.m = 4; d.K = 2048; d.N = 2048; r = it - CONV_E3; d.kb = r >> 6; d.nb = r & 63; }
    else if (it < CONV_E5) { d.m = 5; d.K = 2048; d.N = 11264; r = it - CONV_E4; d.kb = r / 352; d.nb = r - d.kb * 352; }
    else { d.m = 6; d.K = 5632; d.N = 2048; r = it - CONV_E5; d.kb = r >> 6; d.nb = r & 63; }
    return d;
}
__device__ __forceinline__ const GAS float* conv_src(const Ctx& c, int l, const ConvItem& d) {
    const int ii = d.m == 0 ? 2 : d.m == 1 ? 11 : d.m == 2 ? 14 : d.m == 3 ? 26 : d.m == 4 ? 27 : d.m == 5 ? 30 : 32;
    return inp(c, ii) + (size_t)l * ((size_t)d.K * d.N);
}
template <int DEP> __device__ __forceinline__ void conv_items(const Ctx& c0, int l, int b0, int b1, int wIdx, int nW) { const Ctx c = fresh(c0);
    LAS float* scr = (LAS float*)(c.lds + c.wave * 8704);
    LAS float* GB = (LAS float*)(c.lds + 8 * 8704);
    __syncthreads();
    { const int t4 = c.tid * 4; f32x4 gi = (f32x4){1.f, 1.f, 1.f, 1.f}, bi = (f32x4){0.f, 0.f, 0.f, 0.f};
      if (l > 0) { gi = *(const GAS f32x4*)(inp(c, 33) + (size_t)(l - 1) * D + t4); bi = *(const GAS f32x4*)(inp(c, 34) + (size_t)(l - 1) * D + t4); }
      const f32x4 gu = *(const GAS f32x4*)(inp(c, 28) + (size_t)l * D + t4), bu = *(const GAS f32x4*)(inp(c, 29) + (size_t)l * D + t4);
      *(LAS f32x4*)(GB + t4) = gi; *(LAS f32x4*)(GB + 2048 + t4) = bi; *(LAS f32x4*)(GB + 4096 + t4) = gu; *(LAS f32x4*)(GB + 6144 + t4) = bu; }
    __syncthreads();
    const int lane = c.lane, kr = lane >> 3, ns = lane & 7;
    int it = b0 + wIdx;
    if (it >= b1) return;
    const int last = b1 - 1;
    f32x4 q0[8], q1[8], q2[8], q3[8];
#define TR_LOAD(dst, item_) do { int item = (item_); item = item < last ? item : last; const ConvItem d_ = conv_decode(item); const GAS float* src_ = conv_src(c, l, d_) + (size_t)(64 * d_.kb + kr) * d_.N + 32 * d_.nb + 4 * ns; \
        _Pragma("unroll") for (int i = 0; i < 8; ++i) dst[i] = __builtin_nontemporal_load((const GAS f32x4*)(src_ + (size_t)(8 * i) * d_.N)); } while (0)
#define TR_PROC(src, item) do { \
        const ConvItem d = conv_decode(item); const int m = d.m, K = d.K, N = d.N, kb = d.kb, k0 = 64 * d.kb, n0 = 32 * d.nb; \
        const int mode = m == 0 ? 1 : m == 1 ? 2 : m == 5 ? 3 : 0; const bool fold = (m == 0) || (m == 5); \
        const size_t wsoff = m == 0 ? WS_WIN : m == 1 ? WS_WGLU : m == 2 ? WS_WRET : m == 3 ? WS_WRWKV : m == 4 ? WS_WO : m == 5 ? WS_WUP : WS_WDOWN; \
        GAS bf16* WT = (GAS bf16*)(wsp(c) + wsoff) + (size_t)l * ((size_t)K * N); \
        GAS float* P1 = (GAS float*)(wsp(c) + WS_PART) + (size_t)l * 64 * (NIN + 11264) + (m == 5 ? 64 * NIN : 0); GAS float* P2 = P1 + 32 * N;        \
        _Pragma("unroll") for (int i = 0; i < 8; ++i) { _Pragma("unroll") for (int e = 0; e < 4; ++e) scr[(8 * i + kr) * 33 + 4 * ns + e] = src[i][e]; } \
        LDS_WAIT(); asm volatile("" ::: "memory"); \
        const int cch = lane & 7; \
        f32x4 g0 = (f32x4){1.f, 1.f, 1.f, 1.f}, g1 = g0, b0v = (f32x4){0.f, 0.f, 0.f, 0.f}, b1v = b0v; \
        if (fold) { const LAS float* gb = GB + (m == 5 ? 4096 : 0) + k0 + 8 * cch; g0 = *(const LAS f32x4*)gb; g1 = *(const LAS f32x4*)(gb + 4); b0v = *(const LAS f32x4*)(gb + 2048); b1v = *(const LAS f32x4*)(gb + 2052); } \
        _Pragma("unroll") for (int j = 0; j < 4; ++j) { const int n = (lane >> 3) + 8 * j; const LAS float* sp = scr + (8 * cch) * 33 + n; \
            const f32x4 w0 = (f32x4){sp[0 * 33], sp[1 * 33], sp[2 * 33], sp[3 * 33]}, w1 = (f32x4){sp[4 * 33], sp[5 * 33], sp[6 * 33], sp[7 * 33]}; \
            const u32x4 o = pack8(w0 * g0, w1 * g1); const int dr = dst_row(mode, n0 + n); \
            __builtin_nontemporal_store(o, (GAS u32x4*)(WT + (size_t)dr * K + k0 + 8 * cch)); \
            if (fold) { f32x4 u0, u1; unpack8(o, u0, u1); const f32x4 e0 = w0 * b0v, e1 = w1 * b1v; \
                float p1 = ((u0[0] + u0[1]) + (u0[2] + u0[3])) + ((u1[0] + u1[1]) + (u1[2] + u1[3])), p2 = ((e0[0] + e0[1]) + (e0[2] + e0[3])) + ((e1[0] + e1[1]) + (e1[2] + e1[3])); \
                p1 += __shfl_xor(p1, 1); p1 += __shfl_xor(p1, 2); p1 += __shfl_xor(p1, 4); p2 += __shfl_xor(p2, 1); p2 += __shfl_xor(p2, 2); p2 += __shfl_xor(p2, 4); \
                if (cch == 0) { P1[(size_t)kb * N + dr] = p1; P2[(size_t)kb * N + dr] = p2; } } } \
        LDS_WAIT(); asm volatile("" ::: "memory"); } while (0)
    if constexpr (DEP == 3) {
        TR_LOAD(q0, it); TR_LOAD(q1, it + nW); TR_LOAD(q2, it + 2 * nW);
#pragma nounroll
        for (;;) {
            TR_LOAD(q3, it + 3 * nW); TR_PROC(q0, it); it += nW; if (it >= b1) break;
            TR_LOAD(q0, it + 3 * nW); TR_PROC(q1, it); it += nW; if (it >= b1) break;
            TR_LOAD(q1, it + 3 * nW); TR_PROC(q2, it); it += nW; if (it >= b1) break;
            TR_LOAD(q2, it + 3 * nW); TR_PROC(q3, it); it += nW; if (it >= b1) break;
        }
    } else {
        TR_LOAD(q0, it);
#pragma nounroll
        for (;;) {
            TR_LOAD(q1, it + nW); TR_PROC(q0, it); it += nW; if (it >= b1) break;
            TR_LOAD(q0, it + nW); TR_PROC(q1, it); it += nW; if (it >= b1) break;
        }
    }
#undef TR_LOAD
#undef TR_PROC
}
__device__ __forceinline__ void ssm_prep_item(const Ctx& c, int l, int g) {
    LAS float* APOW = (LAS float*)c.lds;
    LAS float* BB = APOW + 17 * 128;
    LAS float* CC = BB + 2048;
    LAS float* KT = CC + 2048;
    LAS float* FF = KT + 4096;
    const int lg = l * 64 + g, tid = c.tid;
    const GAS float* b_re = inp(c, 6) + (size_t)lg * 1024; const GAS float* b_im = inp(c, 7) + (size_t)lg * 1024;
    const GAS float* c_re = inp(c, 8) + (size_t)lg * 1024; const GAS float* c_im = inp(c, 9) + (size_t)lg * 1024;
    if (tid < 64) {
        const float step = __expf(inp(c, 5)[lg]), lr = inp(c, 3)[lg * 64 + tid], li = inp(c, 4)[lg * 64 + tid];
        const float x = lr * step, y = li * step;
        for (int d = 0; d <= 16; ++d) { const float mag = __expf(x * (float)d), ang = y * (float)d; float sn, cs; sincos_cw(ang, sn, cs); APOW[(d * 64 + tid) * 2] = mag * cs; APOW[(d * 64 + tid) * 2 + 1] = mag * sn; }
        float sy, cy, sh, chh; sincos_cw(y, sy, cy); sincos_cw(0.5f * y, sh, chh);
        const float em1 = (fabsf(x) < 0.1f) ? x * (1.f + x * (0.5f + x * (0.16666667f + x * (0.041666668f + x * (0.0083333338f + x * 0.0013888889f))))) : (__expf(x) - 1.f);
        const float re1 = em1 * cy - 2.f * sh * sh, im1 = (em1 + 1.f) * sy, den = lr * lr + li * li;
        FF[tid * 2] = (re1 * lr + im1 * li) / den; FF[tid * 2 + 1] = (im1 * lr - re1 * li) / den;
    }
    __syncthreads();
    for (int idx = tid; idx < 1024; idx += 512) { const int p = idx >> 4; const float br = b_re[idx], bi = b_im[idx], fr = FF[p * 2], fi = FF[p * 2 + 1];
        BB[idx * 2] = fr * br - fi * bi; BB[idx * 2 + 1] = fr * bi + fi * br; CC[idx * 2] = c_re[idx]; CC[idx * 2 + 1] = c_im[idx]; }
    __syncthreads();
    for (int e = tid; e < 4096; e += 512) { const int d = e >> 8, ch = (e >> 4) & 15, c2 = e & 15; float s = 0.f;
        for (int p = 0; p < 64; ++p) { const float ar = APOW[(d * 64 + p) * 2], ai = APOW[(d * 64 + p) * 2 + 1], br = BB[(p * 16 + c2) * 2], bi = BB[(p * 16 + c2) * 2 + 1];
            const float er = ar * br - ai * bi, ei = ar * bi + ai * br; s += CC[(ch * 64 + p) * 2] * er - CC[(ch * 64 + p) * 2 + 1] * ei; }
        KT[e] = s; }
    __syncthreads();
    GAS bf16* MST = (GAS bf16*)(wsp(c) + WS_MST) + (size_t)lg * 65536;
    for (int e = tid; e < 8192; e += 512) { const int r = e >> 5, k8 = e & 31, j = k8 >> 1, c2b = (k8 & 1) * 8; float v[8];
#pragma unroll
        for (int q = 0; q < 8; ++q) { v[q] = 0.f;
            if (r < 128) { const int p = r & 63; const float ar = APOW[((15 - j) * 64 + p) * 2], ai = APOW[((15 - j) * 64 + p) * 2 + 1], br = BB[(p * 16 + c2b + q) * 2], bi = BB[(p * 16 + c2b + q) * 2 + 1];
                v[q] = (r < 64) ? (ar * br - ai * bi) : (ar * bi + ai * br); } }
        u32x4 o; o.x = cvt_pk_bf16(v[0], v[1]); o.y = cvt_pk_bf16(v[2], v[3]); o.z = cvt_pk_bf16(v[4], v[5]); o.w = cvt_pk_bf16(v[6], v[7]);
        *(GAS u32x4*)(MST + (size_t)r * 256 + k8 * 8) = o; }
    GAS bf16* MIC = (GAS bf16*)(wsp(c) + WS_MIC) + (size_t)lg * 98304;
    for (int e = tid; e < 12288; e += 512) { const int r = e / 48, k8 = e % 48, i = r >> 4, ch = r & 15; float v[8];
#pragma unroll
        for (int q = 0; q < 8; ++q) {
            if (k8 < 32) { const int j = k8 >> 1, c2 = (k8 & 1) * 8 + q; v[q] = (j <= i) ? KT[((i - j) * 16 + ch) * 16 + c2] : 0.f; }
            else { const int p = ((k8 - 32) & 7) * 8 + q; const float ar = APOW[((i + 1) * 64 + p) * 2], ai = APOW[((i + 1) * 64 + p) * 2 + 1], cr = CC[(ch * 64 + p) * 2], ci = CC[(ch * 64 + p) * 2 + 1];
                v[q] = (k8 < 40) ? (cr * ar - ci * ai) : -(cr * ai + ci * ar); } }
        u32x4 o; o.x = cvt_pk_bf16(v[0], v[1]); o.y = cvt_pk_bf16(v[2], v[3]); o.z = cvt_pk_bf16(v[4], v[5]); o.w = cvt_pk_bf16(v[6], v[7]);
        *(GAS u32x4*)(MIC + (size_t)r * 384 + k8 * 8) = o; }
    if (tid < 64) { GAS float* AL = (GAS float*)(wsp(c) + WS_AL) + (size_t)(lg * 64 + tid) * 2; AL[0] = APOW[(16 * 64 + tid) * 2]; AL[1] = APOW[(16 * 64 + tid) * 2 + 1]; }
    __syncthreads();
}
__device__ __forceinline__ void prologue(const Ctx& c0) { const Ctx c = fresh(c0);
    for (int it = c.bx; it < DEPTH * 64; it += c.G) ssm_prep_item(c, it >> 6, it & 63);
    const int gt = c.bx * 512 + c.tid, NT = c.G * 512;
    { const int* pos = (const int*)inp(c, 1); GAS float* rc = (GAS float*)(wsp(c) + WS_ROPE); GAS float* rs = rc + T * 64; GAS float* rct = rs + T * 64; GAS float* rst = rct + T * 64;
      for (int idx = gt; idx < T * 64; idx += NT) { const int t = idx >> 6, i = idx & 63; const float inv = ex2(-(float)i * (13.287712379549449f / 64.f)), ang = (float)pos[t] * inv;
          float cv, sv; sincos_cw(ang, sv, cv); rc[idx] = cv; rs[idx] = sv; }
      for (int idx = gt; idx < T * 64; idx += NT) { const int i = idx / T, t = idx % T; const float inv = ex2(-(float)i * (13.287712379549449f / 64.f)), ang = (float)pos[t] * inv;
          float cv, sv; sincos_cw(ang, sv, cv); rct[idx] = cv; rst[idx] = sv; } }
    for (int l = 0; l < DEPTH; ++l) { GAS bf16* WLR = (GAS bf16*)(wsp(c) + WS_WLR) + (size_t)l * 3072 * 256;
        const GAS float* w2 = inp(c, 17) + (size_t)l * 64 * 1024; const GAS float* a2 = inp(c, 19) + (size_t)l * 64 * 1024; const GAS float* g2 = inp(c, 20) + (size_t)l * 128 * 1024;
        for (int idx = gt; idx < 3072 * 32; idx += NT) { const int row = idx % 3072, k8 = idx / 3072, part = row >> 10, cc = row & 1023; float v[8];
#pragma unroll
            for (int q = 0; q < 8; ++q) { const int k = k8 * 8 + q; float x = 0.f;
                if (part == 0 && k < 64) x = w2[(size_t)k * 1024 + cc];
                if (part == 1 && k >= 64 && k < 128) x = a2[(size_t)(k - 64) * 1024 + cc];
                if (part == 2 && k >= 128) x = g2[(size_t)(k - 128) * 1024 + cc];
                v[q] = x; }
            u32x4 o; o.x = cvt_pk_bf16(v[0], v[1]); o.y = cvt_pk_bf16(v[2], v[3]); o.z = cvt_pk_bf16(v[4], v[5]); o.w = cvt_pk_bf16(v[6], v[7]);
            *(GAS u32x4*)(WLR + (size_t)row * 256 + k8 * 8) = o; } }
    { GAS long long* st = (GAS long long*)(wsp(c) + WS_STATS2);
      for (int idx = gt; idx < T * 2; idx += NT) st[idx] = (idx & 1) ? (long long)((double)D * (1.0 - 1e-5) * 1048576.0) : 0ll; }
    { GAS unsigned* z = (GAS unsigned*)(wsp(c) + WS_X1B); for (int idx = gt; idx < 2 * D / 2; idx += NT) z[idx] = 0u; }
    { const GAS float* x = inp(c, 0); GAS bf16* XB = (GAS bf16*)(wsp(c) + WS_XB);
      for (int idx0 = gt; idx0 < T * D / 8; idx0 += 4 * NT) { f32x4 a[4], b[4];
#pragma unroll
          for (int k = 0; k < 4; ++k) { const int idx = idx0 + k * NT; if (idx < T * D / 8) { a[k] = *(const GAS f32x4*)(x + (size_t)idx * 8); b[k] = *(const GAS f32x4*)(x + (size_t)idx * 8 + 4); } }
#pragma unroll
          for (int k = 0; k < 4; ++k) { const int idx = idx0 + k * NT; if (idx < T * D / 8) *(GAS u32x4*)(XB + (size_t)idx * 8) = pack8(a[k], b[k]); } } }
    __syncthreads();
    PRB(900) for (int l = 0; l < DEPTH; ++l) { const int p0 = (DEFER_CONV && l > 0) ? CONV_B3 : 0; if (p0 < CONV_TOT) conv_items<1>(c, l, p0, CONV_TOT, c.gw, c.NGW); }
}
__device__ __forceinline__ void c12_reduce(const Ctx& c0, int l0, int l1) { const Ctx c = fresh(c0);
    GAS float* C12 = (GAS float*)(wsp(c) + WS_C12); const GAS float* PART = (const GAS float*)(wsp(c) + WS_PART);
    for (int idx = l0 * C12_STRIDE + c.bx * 512 + c.tid; idx < l1 * C12_STRIDE; idx += c.G * 512) { const int l = idx / C12_STRIDE, r = idx % C12_STRIDE;
        const GAS float* p; int N;
        if (r < 2 * NIN) { N = NIN; p = PART + (size_t)l * 64 * (NIN + 11264) + (r < NIN ? r : 32 * NIN + (r - NIN)); }
        else { N = 11264; const int r2 = r - 2 * NIN; p = PART + (size_t)l * 64 * (NIN + 11264) + 64 * NIN + (r2 < 11264 ? r2 : 32 * 11264 + (r2 - 11264)); }
        float sacc = 0.f;
        float pv[32];
#pragma unroll
        for (int kb = 0; kb < 32; ++kb) pv[kb] = p[(size_t)kb * N];
#pragma unroll
        for (int kb = 0; kb < 32; ++kb) sacc += pv[kb];
        C12[idx] = sacc; }
}
__device__ __forceinline__ void ssm_scan(const Ctx& c0, int l) { const Ctx c = fresh(c0);
    const int gsel = (c.G >= 192) ? c.bx - 128 : c.bx;
    if (gsel < 0 || gsel >= 64) return;
    const int g = gsel, p = c.lane, w = c.wave;
    const GAS float* AL = (const GAS float*)(wsp(c) + WS_AL) + (size_t)((l * 64 + g) * 64 + p) * 2; const float ar = AL[0], ai = AL[1];
    const GAS float* SL = (const GAS float*)(wsp(c) + WS_SLOC) + (size_t)(g * 512 + 64 * w) * 128 + p; GAS bf16* U2 = (GAS bf16*)(wsp(c) + WS_U2) + (size_t)(g * 512 + 64 * w) * 384 + 256 + p;
    float lr[32], li[32];
    float er = 0.f, ei = 0.f;
#pragma nounroll
    for (int hf = 0; hf < 2; ++hf) {
#pragma unroll
        for (int q = 0; q < 32; ++q) { lr[q] = SL[(size_t)(32 * hf + q) * 128]; li[q] = SL[(size_t)(32 * hf + q) * 128 + 64]; }
#pragma unroll
        for (int q = 0; q < 32; ++q) { const float nr = ar * er - ai * ei + lr[q], ni = ar * ei + ai * er + li[q]; er = nr; ei = ni; } }
    float pr = ar, pi = ai;
#pragma unroll
    for (int q = 0; q < 6; ++q) { const float nr = pr * pr - pi * pi, ni = 2.f * pr * pi; pr = nr; pi = ni; }
    LAS float* EX = (LAS float*)c.lds;
    EX[(w * 64 + p) * 2] = er; EX[(w * 64 + p) * 2 + 1] = ei;
    __syncthreads();
    float sr = 0.f, si = 0.f;
    for (int v = 0; v < w; ++v) { const float xr = EX[(v * 64 + p) * 2], xi = EX[(v * 64 + p) * 2 + 1]; const float nr = pr * sr - pi * si + xr, ni = pr * si + pi * sr + xi; sr = nr; si = ni; }
    __syncthreads();
#pragma nounroll
    for (int hf = 0; hf < 2; ++hf) {
#pragma unroll
        for (int q = 0; q < 32; ++q) { lr[q] = SL[(size_t)(32 * hf + q) * 128]; li[q] = SL[(size_t)(32 * hf + q) * 128 + 64]; }
#pragma unroll
        for (int q = 0; q < 32; ++q) { U2[(size_t)(32 * hf + q) * 384] = f2bf(sr); U2[(size_t)(32 * hf + q) * 384 + 64] = f2bf(si);
            const float nr = ar * sr - ai * si + lr[q], ni = ar * si + ai * sr + li[q]; sr = nr; si = ni; } }
}
template <int CTRL> __device__ __forceinline__ float dpp_mov(float x) { return __builtin_bit_cast(float, __builtin_amdgcn_mov_dpp(__builtin_bit_cast(int, x), CTRL, 0xf, 0xf, true)); }
__device__ __forceinline__ float row16_sum(float x) { x += dpp_mov<0x121>(x); x += dpp_mov<0x122>(x); x += dpp_mov<0x124>(x); x += dpp_mov<0x128>(x); return x; }
__device__ __forceinline__ float wave_sum_dpp(float x) {
    x += dpp_mov<0x121>(x); x += dpp_mov<0x122>(x); x += dpp_mov<0x124>(x); x += dpp_mov<0x128>(x);
    const int xi = __builtin_bit_cast(int, x);
    return (__builtin_bit_cast(float, __builtin_amdgcn_readlane(xi, 0)) + __builtin_bit_cast(float, __builtin_amdgcn_readlane(xi, 16))) + (__builtin_bit_cast(float, __builtin_amdgcn_readlane(xi, 32)) + __builtin_bit_cast(float, __builtin_amdgcn_readlane(xi, 48)));
}
constexpr int RP = 136;
__device__ __forceinline__ void tile_fetch(u32x4 (&r)[4], const GAS bf16* g, size_t pitch, int tid) {
#pragma unroll
    for (int q = 0; q < 4; ++q) { const int idx = tid + 512 * q, row = idx >> 4, c8 = idx & 15; r[q] = *(const GAS u32x4*)(g + (size_t)row * pitch + c8 * 8); }
}
__device__ __forceinline__ void tile_commit(LAS bf16* s, const u32x4 (&r)[4], int tid) {
#pragma unroll
    for (int q = 0; q < 4; ++q) { const int idx = tid + 512 * q, row = idx >> 4, c8 = idx & 15; *(LAS u32x4*)(s + row * RP + c8 * 8) = r[q]; }
}
template <bool SWAP = false>
__device__ __forceinline__ void mm_rows16(f32x4 (&acc)[8], const LAS bf16* sA, const LAS bf16* sB, int w, int lane) {
    const int l15 = lane & 15, lq = lane >> 4;
#pragma unroll
    for (int ks = 0; ks < 4; ++ks) { const bf16x8 a = *(const LAS bf16x8*)(sA + (16 * w + l15) * RP + ks * 32 + 8 * lq);
#pragma unroll
        for (int ct = 0; ct < 8; ++ct) { const bf16x8 b = *(const LAS bf16x8*)(sB + (16 * ct + l15) * RP + ks * 32 + 8 * lq); acc[ct] = SWAP ? __builtin_amdgcn_mfma_f32_16x16x32_bf16(b, a, acc[ct], 0, 0, 0) : __builtin_amdgcn_mfma_f32_16x16x32_bf16(a, b, acc[ct], 0, 0, 0); } }
}
__device__ __forceinline__ void ret_kv_phase(const Ctx& c0) { const Ctx c = fresh(c0);
    LAS bf16* sA = (LAS bf16*)c.lds; LAS bf16* sB = sA + 128 * RP;
    const GAS bf16* RVT = (const GAS bf16*)(wsp(c) + WS_RVT); const GAS bf16* RKT = (const GAS bf16*)(wsp(c) + WS_RKT); GAS float* KVT = (GAS float*)(wsp(c) + WS_KVT);
    u32x4 ta[4], tb[4];
#define RKV_FETCH(it_) do { const int n_ = (it_) >> 3, h_ = (it_) & 7; tile_fetch(ta, RVT + (size_t)(128 * h_) * T + 128 * n_, T, c.tid); tile_fetch(tb, RKT + (size_t)(128 * h_) * T + 128 * n_, T, c.tid); } while (0)
    const bool bal = (c.G == 256);
#define RKV_ITEM(k_) (bal ? (c.bx < 128 ? ((k_) == 0 ? 384 + c.bx : -1) : ((k_) < 3 ? (c.bx - 128) + 128 * (k_) : -1)) : (c.bx + (k_) * c.G < 512 ? c.bx + (k_) * c.G : -1))
    int it = RKV_ITEM(0); if (it >= 0) RKV_FETCH(it);
    for (int k3 = 0; it >= 0; ++k3) { const int n = it >> 3, h = it & 7;
        tile_commit(sA, ta, c.tid); tile_commit(sB, tb, c.tid);
        __syncthreads();
        const int itn = RKV_ITEM(k3 + 1); if (itn >= 0) RKV_FETCH(itn);
        f32x4 acc[8];
#pragma unroll
        for (int ct = 0; ct < 8; ++ct) acc[ct] = (f32x4){0.f, 0.f, 0.f, 0.f};
        mm_rows16<true>(acc, sA, sB, c.wave, c.lane);
        GAS float* dst = KVT + (size_t)(n * 8 + h) * 16384; const int l15 = c.lane & 15, lq = c.lane >> 4;
#pragma unroll
        for (int ct = 0; ct < 8; ++ct) *(GAS f32x4*)(dst + (16 * c.wave + l15) * 128 + 16 * ct + 4 * lq) = acc[ct];
        __syncthreads(); it = itn; }
#undef RKV_ITEM
#undef RKV_FETCH
}
__device__ __forceinline__ void ret_scan_phase(const Ctx& c0) { const Ctx c = fresh(c0);
    const GAS float* KVT = (const GAS float*)(wsp(c) + WS_KVT); GAS bf16* PV = (GAS bf16*)(wsp(c) + WS_PREVT);
    for (int e = c.bx * 512 + c.tid; e < 8 * 16384; e += c.G * 512) { const int h = e >> 14;
        const float lg = l2gamma(h), g1 = ex2(lg), g127 = ex2(127.f * lg), g128 = ex2(128.f * lg);
        const int off = (h << 14) + (e & 16383); float st = 0.f;
        for (int n0 = 0; n0 < 64; n0 += 8) { float kv[8];
#pragma unroll
            for (int q = 0; q < 8; ++q) kv[q] = KVT[(size_t)(n0 + q) * 8 * 16384 + off];
#pragma unroll
            for (int q = 0; q < 8; ++q) { PV[(size_t)(n0 + q) * 8 * 16384 + off] = f2bf(g1 * st); st = g128 * st + g127 * kv[q]; } } }
}
__device__ __forceinline__ void ret_out_phase(const Ctx& c0, int l) { const Ctx c = fresh(c0);
    LAS bf16* sQ = (LAS bf16*)c.lds; LAS bf16* sK = sQ + 128 * RP; LAS bf16* sV = sK + 128 * RP; LAS bf16* sP = sV + 128 * RP;
    const GAS bf16* RQ = (const GAS bf16*)(wsp(c) + WS_RQ); const GAS bf16* RK = (const GAS bf16*)(wsp(c) + WS_RK); const GAS bf16* RVT = (const GAS bf16*)(wsp(c) + WS_RVT); const GAS bf16* PV = (const GAS bf16*)(wsp(c) + WS_PREVT);
    const GAS bf16* RG = (const GAS bf16*)(wsp(c) + WS_RG); GAS bf16* ORET = (GAS bf16*)(wsp(c) + WS_ORET);
    const GAS float* ng = inp(c, 12) + l * 1024; const GAS float* nb = inp(c, 13) + l * 1024;
    const int w = c.wave, l15 = c.lane & 15, lq = c.lane >> 4;
    const bool bal = (c.G == 256);
    u32x4 tq[4], tk[4], tv[4], tp[4];
#define ROUT_ITEM(k3_) (bal ? (c.bx < 128 ? ((k3_) == 0 ? 384 + c.bx : -1) : ((k3_) < 3 ? (c.bx - 128) + 128 * (k3_) : -1)) : (c.bx + (k3_) * c.G < 512 ? c.bx + (k3_) * c.G : -1))
#define ROUT_FETCH(it_) do { const int n_ = (it_) >> 3, h_ = (it_) & 7; tile_fetch(tq, RQ + (size_t)(128 * n_) * 1024 + 128 * h_, 1024, c.tid); tile_fetch(tk, RK + (size_t)(128 * n_) * 1024 + 128 * h_, 1024, c.tid); \
        tile_fetch(tv, RVT + (size_t)(128 * h_) * T + 128 * n_, T, c.tid); tile_fetch(tp, PV + (size_t)(n_ * 8 + h_) * 16384, 128, c.tid); } while (0)
    int it = ROUT_ITEM(0); if (it >= 0) ROUT_FETCH(it);
    for (int k3 = 0; it >= 0; ++k3) {
        const int n = it >> 3, h = it & 7;
        u32x2 rgv[8]; f32x4 ngv[8], nbv[8];
#pragma unroll
        for (int ct = 0; ct < 8; ++ct) { const int col = 128 * h + 16 * ct + 4 * lq; rgv[ct] = *(const GAS u32x2*)(RG + (size_t)(128 * n + 16 * w + l15) * 1024 + col); ngv[ct] = *(const GAS f32x4*)(ng + col); nbv[ct] = *(const GAS f32x4*)(nb + col); }
        tile_commit(sQ, tq, c.tid); tile_commit(sK, tk, c.tid); tile_commit(sV, tv, c.tid); tile_commit(sP, tp, c.tid);
        __syncthreads();
        const int itn = ROUT_ITEM(k3 + 1); if (itn >= 0) ROUT_FETCH(itn);
        f32x4 acc[8];
#pragma unroll
        for (int ct = 0; ct < 8; ++ct) acc[ct] = (f32x4){0.f, 0.f, 0.f, 0.f};
        mm_rows16(acc, sQ, sK, w, c.lane);
        __syncthreads();
#pragma unroll
        for (int ct = 0; ct < 8; ++ct)
#pragma unroll
            for (int r = 0; r < 4; ++r) { const int i = 16 * w + 4 * lq + r, j = 16 * ct + l15; sK[i * RP + j] = f2bf(j <= i ? acc[ct][r] : 0.f); }
        LDS_WAIT(); asm volatile("" ::: "memory");
#pragma unroll
        for (int ct = 0; ct < 8; ++ct) acc[ct] = (f32x4){0.f, 0.f, 0.f, 0.f};
        mm_rows16<true>(acc, sK, sV, w, c.lane);
        mm_rows16<true>(acc, sQ, sP, w, c.lane);
        { const int t = 128 * n + 16 * w + l15; f32x4 s4 = acc[0];
#pragma unroll
          for (int ct = 1; ct < 8; ++ct) s4 = s4 + acc[ct];
          float s = (s4[0] + s4[1]) + (s4[2] + s4[3]); s += __shfl_xor(s, 16); s += __shfl_xor(s, 32);
          const float mean = s * (1.f / 128.f); f32x4 q4 = (f32x4){0.f, 0.f, 0.f, 0.f};
#pragma unroll
          for (int ct = 0; ct < 8; ++ct) { const f32x4 d = acc[ct] - mean; q4 = q4 + d * d; }
          float q = (q4[0] + q4[1]) + (q4[2] + q4[3]); q += __shfl_xor(q, 16); q += __shfl_xor(q, 32);
          const float rstd = rsq(q * (1.f / 128.f) + GN_EPS);
#pragma unroll
          for (int ct = 0; ct < 8; ++ct) { const int col = 128 * h + 16 * ct + 4 * lq; const u32x2 rg = rgv[ct];
              const f32x4 gt = (f32x4){bf_lo(rg.x), bf_hi(rg.x), bf_lo(rg.y), bf_hi(rg.y)};
              const f32x4 o = ((acc[ct] - mean) * rstd * ngv[ct] + nbv[ct]) * gt;
              u32x2 ob; ob.x = cvt_pk_bf16(o[0], o[1]); ob.y = cvt_pk_bf16(o[2], o[3]); *(GAS u32x2*)(ORET + (size_t)t * 1024 + col) = ob; } }
        __syncthreads(); it = itn; }
#undef ROUT_ITEM
#undef ROUT_FETCH
}
__device__ __forceinline__ void rwkv_a_phase(const Ctx& c0, int l) { const Ctx c = fresh(c0);
    const GAS bf16* ZR = (const GAS bf16*)(wsp(c) + WS_ZR); GAS bf16* ALR = (GAS bf16*)(wsp(c) + WS_ALR); const GAS float* mu = inp(c, 15) + (size_t)l * RWKV_IN + 3072;
    const int NT = c.G * 512;
    for (int idx0 = c.bx * 512 + c.tid; idx0 < T * 32; idx0 += 2 * NT) {
        u32x4 zc[2], zp[2]; f32x4 m0[2], m1[2];
#pragma unroll
        for (int k = 0; k < 2; ++k) { const int idx = idx0 + k * NT; if (idx < T * 32) { const int t = idx >> 5, c8 = idx & 31;
            zc[k] = *(const GAS u32x4*)(ZR + (size_t)t * RWKV_IN + 3072 + c8 * 8); zp[k] = (u32x4){0u, 0u, 0u, 0u};
            if (t > 0) zp[k] = *(const GAS u32x4*)(ZR + (size_t)(t - 1) * RWKV_IN + 3072 + c8 * 8);
            m0[k] = *(const GAS f32x4*)(mu + c8 * 8); m1[k] = *(const GAS f32x4*)(mu + c8 * 8 + 4); } }
#pragma unroll
        for (int k = 0; k < 2; ++k) { const int idx = idx0 + k * NT; if (idx < T * 32) { const int t = idx >> 5, c8 = idx & 31;
            f32x4 z0, z1, p0, p1; unpack8(zc[k], z0, z1); unpack8(zp[k], p0, p1);
            f32x4 s0 = z0 + m0[k] * (p0 - z0), s1 = z1 + m1[k] * (p1 - z1);
            if (c8 < 8) {
#pragma unroll
                for (int j = 0; j < 4; ++j) { s0[j] = 2.f * sigm(2.f * s0[j]) - 1.f; s1[j] = 2.f * sigm(2.f * s1[j]) - 1.f; } }
            else if (c8 >= 16) { s0 = sigm4(s0); s1 = sigm4(s1); }
            *(GAS u32x4*)(ALR + (size_t)t * 256 + c8 * 8) = pack8(s0, s1); } } }
}
constexpr int RP2 = 72;
template <bool SWAP = false>
__device__ __forceinline__ f32x4 mm16(f32x4 acc, const LAS bf16* sA, const LAS bf16* sB, int lane) {
    const int l15 = lane & 15, q = lane >> 4;
#pragma unroll
    for (int s2 = 0; s2 < 2; ++s2) { const bf16x8 a = *(const LAS bf16x8*)(sA + l15 * RP2 + 32 * s2 + 8 * q), b = *(const LAS bf16x8*)(sB + l15 * RP2 + 32 * s2 + 8 * q);
        acc = SWAP ? __builtin_amdgcn_mfma_f32_16x16x32_bf16(b, a, acc, 0, 0, 0) : __builtin_amdgcn_mfma_f32_16x16x32_bf16(a, b, acc, 0, 0, 0); }
    return acc;
}
__device__ __forceinline__ u32x4 frag_kperm(const LAS bf16* srow, int s2, int q) {
    const u32x2 lo = *(const LAS u32x2*)(srow + 32 * s2 + 4 * q), hi = *(const LAS u32x2*)(srow + 32 * s2 + 16 + 4 * q); return (u32x4){lo.x, lo.y, hi.x, hi.y};
}
__device__ __forceinline__ void rw1_phase(const Ctx& c0, int l) { const Ctx c = fresh(c0);
    LAS bf16* sAt = (LAS bf16*)c.lds; LAS bf16* sBt = sAt + 64 * RP2; LAS bf16* sKt = sBt + 64 * RP2; LAS bf16* sRt = sKt + 64 * RP2; LAS bf16* sBtT = sRt + 64 * RP2; LAS bf16* sKtT = sBtT + 64 * RP2;
    LAS bf16* sVT = sKtT + 64 * RP2; LAS bf16* sAak = sVT + 64 * RP2; LAS bf16* sArb = sAak + 64 * RP2; LAS bf16* sArk = sArb + 64 * RP2; LAS bf16* sT = sArk + 64 * RP2; LAS bf16* sTT = sT + 64 * RP2;
    LAS bf16* sAab = sTT + 64 * RP2; LAS float* F = (LAS float*)(sAab + 64 * RP2); LAS float* SEG = F + 4096;
    LAS bf16* sUT = sKt; LAS bf16* sW1T = sAt; LAS bf16* sB2T = sBt;
#define RW1_BAR() do { asm volatile("s_waitcnt lgkmcnt(0)" ::: "memory"); __builtin_amdgcn_s_barrier(); asm volatile("" ::: "memory"); } while (0)
    float lw[8], av[8], prm[6]; bf16 zc[8][3], zp0[3];
#define RW1_FETCH(it2) do { const int h2 = (it2) >> 7, n2 = (it2) & 127, col2 = 64 * h2 + c.lane, t02 = 64 * n2 + 8 * c.wave; GAS unsigned char* ws2 = wsp(c); \
        { const GAS float* mu2 = inp(c, 15) + (size_t)l * RWKV_IN; prm[0] = mu2[col2]; prm[1] = mu2[1024 + col2]; prm[2] = mu2[2048 + col2]; prm[3] = (inp(c, 21) + l * 1024)[col2]; prm[4] = (inp(c, 22) + l * 1024)[col2]; prm[5] = (inp(c, 23) + l * 1024)[col2]; } \
        const GAS float* LW2 = (const GAS float*)(ws2 + WS_DEC); const GAS bf16* AA2 = (const GAS bf16*)(ws2 + WS_AA); const GAS bf16* zr2 = (const GAS bf16*)(ws2 + WS_ZR) + (size_t)t02 * RWKV_IN + col2; \
        _Pragma("unroll") for (int i = 0; i < 8; ++i) { const size_t g = (size_t)(t02 + i) * 1024 + col2; lw[i] = LW2[g]; av[i] = bf2f(AA2[g]); \
            _Pragma("unroll") for (int j = 0; j < 3; ++j) { zc[i][j] = zr2[(size_t)i * RWKV_IN + 1024 * j]; if (i == 0) zp0[j] = (t02 > 0) ? zr2[1024 * j - RWKV_IN] : (bf16)0; } } } while (0)
    if (c.bx < 2048) RW1_FETCH(c.bx);
    for (int it = c.bx; it < 2048; it += c.G) { const int h = it >> 7, n = it & 127; const size_t rec = (size_t)(h * 128 + n);
        int w_ = c.wave; asm volatile("" : "+s"(w_)); const int w = w_;
        int lane = c.lane; asm volatile("" : "+v"(lane)); const int tid = w * 64 + lane, l15 = lane & 15, q = lane >> 4;
        GAS unsigned char* ws = wsp(c);
        GAS bf16* BV = (GAS bf16*)(ws + WS_RW);
        PRB(410) { const int k = lane, seg = w, col = 64 * h + k; const int t0 = 64 * n + 8 * seg;
          const float mur = prm[0], muk = prm[1], muv = prm[2], kkc = prm[3], kac = prm[4], rkc = prm[5];
          float run = 0.f;
#pragma unroll
          for (int i = 0; i < 8; ++i) { run += lw[i]; F[(8 * seg + i) * 64 + k] = run; }
          SEG[seg * 64 + k] = run;
          RW1_BAR();
          float off = 0.f;
#pragma unroll
          for (int s2 = 0; s2 < 8; ++s2) off += (s2 < seg) ? SEG[s2 * 64 + k] : 0.f;
#pragma unroll
          for (int i = 0; i < 8; ++i) { const int l = 8 * seg + i; const float lp = F[l * 64 + k] + off, P = __expf(lp), Pm1 = __expf(lp - lw[i]), iP = __expf(-lp);
              float r = bf2f(zc[i][0]), kx = bf2f(zc[i][1]), v = bf2f(zc[i][2]);
              { const bf16 q0 = i ? zc[i > 0 ? i - 1 : 0][0] : zp0[0], q1 = i ? zc[i > 0 ? i - 1 : 0][1] : zp0[1], q2 = i ? zc[i > 0 ? i - 1 : 0][2] : zp0[2];
                r += mur * (bf2f(q0) - r); kx += muk * (bf2f(q1) - kx); v += muv * (bf2f(q2) - v); }
              const float a = av[i], kkr = kx * kkc, nrm = fmaxf(__builtin_amdgcn_sqrtf(wave_sum_dpp(kkr * kkr)), 1e-12f), kk = kkr * __builtin_amdgcn_rcpf(nrm);
              const float kp = kx * (1.f + (a - 1.f) * kac), bb = kk * a, bon = wave_sum_dpp(r * kp * rkc);
              BV[(size_t)(t0 + i) * 1024 + col] = f2bf(bon * v);
              const bf16 bt = f2bf(bb * iP), kt = f2bf(kp * iP);
              sAt[l * RP2 + k] = f2bf(-kk * Pm1); sBt[l * RP2 + k] = bt; sKt[l * RP2 + k] = kt; sRt[l * RP2 + k] = f2bf(r * P);
              sBtT[k * RP2 + l] = bt; sKtT[k * RP2 + l] = kt; sVT[k * RP2 + l] = f2bf(v);
              if (l == 63) ((GAS float*)(ws + WS_PL))[rec * 256 + k] = P; }
          if (it + c.G < 2048) RW1_FETCH(it + c.G);
          RW1_BAR(); }
        PRB(411) { const int p = w >> 1; const LAS bf16* pa = (p < 2) ? sAt : sRt; const LAS bf16* pb = (p & 1) ? sKt : sBt;
#pragma unroll
          for (int i8 = 0; i8 < 8; ++i8) { const int tt = (w & 1) * 8 + i8, mt = tt >> 2, nt = tt & 3;
              const f32x4 a = mm16((f32x4){0.f, 0.f, 0.f, 0.f}, pa + 16 * mt * RP2, pb + 16 * nt * RP2, lane);
#pragma unroll
              for (int r = 0; r < 4; ++r) { const int i = 16 * mt + 4 * q + r, j = 16 * nt + l15; const bool keep = (p < 2) ? (j < i) : (j <= i); const float x = keep ? a[r] : 0.f;
                  if (p == 0) { F[i * 64 + j] = x; sAab[i * RP2 + j] = f2bf(x); } else (p == 1 ? sAak : (p == 2 ? sArb : sArk))[i * RP2 + j] = f2bf(x); } }
          { const int f = tid >> 6, mt = f >> 1, s2 = f & 1; ((GAS u32x4*)(ws + WS_AF))[(rec * 8 + f) * 64 + lane] = frag_kperm(sAt + (16 * mt + l15) * RP2, s2, q); }
          { const int row = tid >> 3, c8 = tid & 7; *(GAS u32x4*)((GAS bf16*)(ws + WS_RT) + rec * 4096 + row * 64 + c8 * 8) = *(const LAS u32x4*)(sRt + row * RP2 + c8 * 8); }
          RW1_BAR(); }
        PRB(412) {
        if (w == 0) { const int hb = lane >> 5, cc = lane & 31; const LAS float* Fb = F + (32 * hb) * 64 + 32 * hb; float Tr[32]; f32x4 fr2[2][8];
            Tr[0] = fmaxf(0.f, 1.f - fabsf((float)cc)); sT[(32 * hb) * RP2 + 32 * hb + cc] = f2bf(Tr[0]);
            fr2[1][0] = *(const LAS f32x4*)(Fb + 64);
#pragma unroll
            for (int i = 1; i < 32; ++i) {
                if (i + 1 < 32) {
#pragma unroll
                    for (int j4 = 0; j4 < (i + 4) / 4; ++j4) fr2[(i + 1) & 1][j4] = *(const LAS f32x4*)(Fb + (i + 1) * 64 + 4 * j4); }
                float ac[4] = {fmaxf(0.f, 1.f - fabsf((float)cc - (float)i)), 0.f, 0.f, 0.f};
#pragma unroll
                for (int j4 = 0; j4 < (i + 3) / 4; ++j4) {
#pragma unroll
                    for (int e = 0; e < 4; ++e) if (4 * j4 + e < i) ac[e] += fr2[i & 1][j4][e] * Tr[4 * j4 + e]; }
                const float a = (ac[0] + ac[1]) + (ac[2] + ac[3]); Tr[i] = a; sT[(32 * hb + i) * RP2 + 32 * hb + cc] = f2bf(a); }
#pragma unroll
            for (int i8 = 0; i8 < 4; ++i8) { u32x4 o; o.x = cvt_pk_bf16(Tr[8 * i8], Tr[8 * i8 + 1]); o.y = cvt_pk_bf16(Tr[8 * i8 + 2], Tr[8 * i8 + 3]); o.z = cvt_pk_bf16(Tr[8 * i8 + 4], Tr[8 * i8 + 5]); o.w = cvt_pk_bf16(Tr[8 * i8 + 6], Tr[8 * i8 + 7]);
                *(LAS u32x4*)(sTT + (32 * hb + cc) * RP2 + 32 * hb + 8 * i8) = o; }
            unsigned zz = 0u; asm volatile("" : "+v"(zz)); const u32x4 z4 = (u32x4){zz, zz, zz, zz};
            *(LAS u32x4*)(sT + cc * RP2 + 32 + 16 * hb) = z4; *(LAS u32x4*)(sT + cc * RP2 + 32 + 16 * hb + 8) = z4;
            *(LAS u32x4*)(sTT + (32 + cc) * RP2 + 16 * hb) = z4; *(LAS u32x4*)(sTT + (32 + cc) * RP2 + 16 * hb + 8) = z4;
            asm volatile("s_waitcnt lgkmcnt(0)" ::: "memory");
            LAS bf16* sMT = (LAS bf16*)SEG;
#pragma unroll
            for (int t4 = 0; t4 < 4; ++t4) { const int mt2 = t4 >> 1, nt2 = t4 & 1;
                const bf16x8 a = *(const LAS bf16x8*)(sAab + (32 + 16 * mt2 + l15) * RP2 + 8 * q), b = *(const LAS bf16x8*)(sTT + (16 * nt2 + l15) * RP2 + 8 * q);
                const f32x4 m4 = __builtin_amdgcn_mfma_f32_16x16x32_bf16(a, b, (f32x4){0.f, 0.f, 0.f, 0.f}, 0, 0, 0);
                u32x2 o; o.x = cvt_pk_bf16(m4[0], m4[1]); o.y = cvt_pk_bf16(m4[2], m4[3]); *(LAS u32x2*)(sMT + (16 * nt2 + l15) * 32 + 16 * mt2 + 4 * q) = o; }
            asm volatile("s_waitcnt lgkmcnt(0)" ::: "memory");
#pragma unroll
            for (int t4 = 0; t4 < 4; ++t4) { const int mt2 = t4 >> 1, nt2 = t4 & 1;
                const bf16x8 a = *(const LAS bf16x8*)(sT + (32 + 16 * mt2 + l15) * RP2 + 32 + 8 * q), b = *(const LAS bf16x8*)(sMT + (16 * nt2 + l15) * 32 + 8 * q);
                const f32x4 t4v = __builtin_amdgcn_mfma_f32_16x16x32_bf16(a, b, (f32x4){0.f, 0.f, 0.f, 0.f}, 0, 0, 0);
#pragma unroll
                for (int r = 0; r < 4; ++r) sT[(32 + 16 * mt2 + 4 * q + r) * RP2 + 16 * nt2 + l15] = f2bf(t4v[r]);
                u32x2 o; o.x = cvt_pk_bf16(t4v[0], t4v[1]); o.y = cvt_pk_bf16(t4v[2], t4v[3]); *(LAS u32x2*)(sTT + (16 * nt2 + l15) * RP2 + 32 + 16 * mt2 + 4 * q) = o; }
        } else {
            for (int tt = w - 1; tt < 16; tt += 7) { const int mt = tt >> 2, vt = tt & 3;
                const f32x4 a = mm16((f32x4){0.f, 0.f, 0.f, 0.f}, sAak + 16 * mt * RP2, sVT + 16 * vt * RP2, lane);
                u32x2 o; o.x = cvt_pk_bf16(a[0], a[1]); o.y = cvt_pk_bf16(a[2], a[3]); *(LAS u32x2*)(sUT + (16 * vt + l15) * RP2 + 16 * mt + 4 * q) = o; }
        }
        RW1_BAR(); }
        PRB(413) {
        if (w < 4) { const int vt = w;
#pragma unroll
            for (int mt = 0; mt < 4; ++mt) { const f32x4 a = mm16((f32x4){0.f, 0.f, 0.f, 0.f}, sT + 16 * mt * RP2, sUT + 16 * vt * RP2, lane);
                u32x2 o; o.x = cvt_pk_bf16(a[0], a[1]); o.y = cvt_pk_bf16(a[2], a[3]); *(LAS u32x2*)(sW1T + (16 * vt + l15) * RP2 + 16 * mt + 4 * q) = o; }
            asm volatile("s_waitcnt lgkmcnt(0)" ::: "memory");
#pragma unroll
            for (int mt = 0; mt < 4; ++mt) {
                f32x4 a = mm16<true>((f32x4){0.f, 0.f, 0.f, 0.f}, sArb + 16 * mt * RP2, sW1T + 16 * vt * RP2, lane); a = mm16<true>(a, sArk + 16 * mt * RP2, sVT + 16 * vt * RP2, lane);
                GAS bf16* dst = (GAS bf16*)(ws + WS_Y0) + rec * 4096;
                { u32x2 o; o.x = cvt_pk_bf16(a[0], a[1]); o.y = cvt_pk_bf16(a[2], a[3]); *(GAS u32x2*)(dst + (16 * mt + l15) * 64 + 16 * vt + 4 * q) = o; }
                f32x4 b = mm16((f32x4){0.f, 0.f, 0.f, 0.f}, sBtT + 16 * mt * RP2, sW1T + 16 * vt * RP2, lane); b = mm16(b, sKtT + 16 * mt * RP2, sVT + 16 * vt * RP2, lane);
                { u32x2 o; o.x = cvt_pk_bf16(b[0], b[1]); o.y = cvt_pk_bf16(b[2], b[3]); ((GAS u32x2*)(ws + WS_VK2F))[(rec * 16 + mt * 4 + vt) * 64 + lane] = o; } }
        } else { const int j = w - 4;
#pragma unroll
            for (int lt = 0; lt < 4; ++lt) { const f32x4 a = mm16((f32x4){0.f, 0.f, 0.f, 0.f}, sBtT + 16 * j * RP2, sTT + 16 * lt * RP2, lane);
#pragma unroll
                for (int r = 0; r < 4; ++r) sB2T[(16 * j + 4 * q + r) * RP2 + 16 * lt + l15] = f2bf(a[r]); }
            asm volatile("s_waitcnt lgkmcnt(0)" ::: "memory");
#pragma unroll
            for (int s2 = 0; s2 < 2; ++s2) ((GAS u32x4*)(ws + WS_BF))[(rec * 8 + 2 * j + s2) * 64 + lane] = frag_kperm(sB2T + (16 * j + l15) * RP2, s2, q);
            GAS bf16* dst = (GAS bf16*)(ws + WS_ARBT) + rec * 4096;
#pragma unroll
            for (int nt = 0; nt < 4; ++nt) { const f32x4 a = mm16<true>((f32x4){0.f, 0.f, 0.f, 0.f}, sArb + 16 * j * RP2, sTT + 16 * nt * RP2, lane);
                u32x2 o; o.x = cvt_pk_bf16(a[0], a[1]); o.y = cvt_pk_bf16(a[2], a[3]); *(GAS u32x2*)(dst + (16 * j + l15) * 64 + 16 * nt + 4 * q) = o; }
        }
        RW1_BAR(); } }
}
#undef RW1_BAR
#undef RW1_FETCH
__device__ __forceinline__ void rw2_phase(const Ctx& c0) { const Ctx c = fresh(c0);
    GAS unsigned char* ws = wsp(c); const int h = c.bx, w = c.wave, lane = c.lane, l15 = lane & 15, q = lane >> 4;
    constexpr int SLOT = 25 * 1024;
    LAS unsigned char* ring = c.lds;
#define RW2_BAR() do { __builtin_amdgcn_s_barrier(); asm volatile("" ::: "memory"); } while (0)
    if (w >= 4) {
        const int j = w & 3;
        const GAS char* gsrc = (j == 0) ? (const GAS char*)(ws + WS_AF) + (size_t)h * 128 * 8192 : (j == 1) ? (const GAS char*)(ws + WS_BF) + (size_t)h * 128 * 8192 : (j == 2) ? (const GAS char*)(ws + WS_VK2F) + (size_t)h * 128 * 8192 : (const GAS char*)(ws + WS_PL) + (size_t)h * 128 * 1024;
        gsrc += lane * 16;
#define RW2_ISSUE(n_) do { LAS unsigned char* sl_ = ring + ((n_) % 5) * SLOT; \
            if (j < 3) { _Pragma("unroll") for (int e = 0; e < 8; ++e) __builtin_amdgcn_global_load_lds((const GAS unsigned*)(gsrc + (size_t)(n_) * 8192 + e * 1024), (LAS unsigned*)(sl_ + j * 8192 + e * 1024), 16, 0, 0); } \
            else __builtin_amdgcn_global_load_lds((const GAS unsigned*)(gsrc + (size_t)(n_) * 1024), (LAS unsigned*)(sl_ + 24 * 1024), 16, 0, 0); } while (0)
#define RW2_WAIT(k8, k1) do { if (j == 3) asm volatile("s_waitcnt vmcnt(" #k1 ")" ::: "memory"); else asm volatile("s_waitcnt vmcnt(" #k8 ")" ::: "memory"); } while (0)
        RW2_ISSUE(0); RW2_ISSUE(1); RW2_ISSUE(2); RW2_ISSUE(3);
        RW2_WAIT(24, 3);
        RW2_BAR();
        for (int n = 0; n < 128; ++n) {
            if (n + 4 < 128) { RW2_ISSUE(n + 4); RW2_WAIT(24, 3); }
            else if (n + 3 < 128) RW2_WAIT(16, 2);
            else if (n + 2 < 128) RW2_WAIT(8, 1);
            else RW2_WAIT(0, 0);
            RW2_BAR();
        }
#undef RW2_ISSUE
#undef RW2_WAIT
    } else {
        const int vt = w;
        GAS bf16* S0B = (GAS bf16*)(ws + WS_S0B) + (size_t)h * 128 * 4096 + (16 * vt + l15) * 64 + 4 * q; GAS bf16* XTB = (GAS bf16*)(ws + WS_XTB) + (size_t)h * 128 * 4096 + (16 * vt + l15) * 64 + 4 * q;
        f32x4 S[4];
#pragma unroll
        for (int kt = 0; kt < 4; ++kt) S[kt] = (f32x4){0.f, 0.f, 0.f, 0.f};
        RW2_BAR();
        for (int n = 0; n < 128; ++n) {
            const LAS unsigned char* sl = ring + (n % 5) * SLOT;
            u32x4 caf[8], cbf[8]; f32x4 cvk[4], cpl[4];
#pragma unroll
            for (int f = 0; f < 8; ++f) caf[f] = *(const LAS u32x4*)(sl + f * 1024 + lane * 16);
#pragma unroll
            for (int f = 0; f < 8; ++f) cbf[f] = *(const LAS u32x4*)(sl + 8192 + f * 1024 + lane * 16);
#pragma unroll
            for (int kt = 0; kt < 4; ++kt) { const u32x2 vk = *(const LAS u32x2*)(sl + 16384 + (kt * 4 + vt) * 512 + lane * 8); cvk[kt] = (f32x4){bf_lo(vk.x), bf_hi(vk.x), bf_lo(vk.y), bf_hi(vk.y)};
                cpl[kt] = *(const LAS f32x4*)(sl + 24 * 1024 + (16 * kt + 4 * q) * 4); }
            u32x4 sb[2];
#pragma unroll
            for (int s2 = 0; s2 < 2; ++s2) { sb[s2].x = cvt_pk_bf16(S[2 * s2][0], S[2 * s2][1]); sb[s2].y = cvt_pk_bf16(S[2 * s2][2], S[2 * s2][3]); sb[s2].z = cvt_pk_bf16(S[2 * s2 + 1][0], S[2 * s2 + 1][1]); sb[s2].w = cvt_pk_bf16(S[2 * s2 + 1][2], S[2 * s2 + 1][3]);
                *(GAS u32x2*)(S0B + (size_t)n * 4096 + 32 * s2) = (u32x2){sb[s2].x, sb[s2].y}; *(GAS u32x2*)(S0B + (size_t)n * 4096 + 32 * s2 + 16) = (u32x2){sb[s2].z, sb[s2].w}; }
            f32x4 X[4];
#pragma unroll
            for (int mt = 0; mt < 4; ++mt) { X[mt] = (f32x4){0.f, 0.f, 0.f, 0.f};
#pragma unroll
                for (int s2 = 0; s2 < 2; ++s2) X[mt] = __builtin_amdgcn_mfma_f32_16x16x32_bf16(__builtin_bit_cast(bf16x8, caf[mt * 2 + s2]), __builtin_bit_cast(bf16x8, sb[s2]), X[mt], 0, 0, 0); }
            u32x4 xb[2];
#pragma unroll
            for (int s2 = 0; s2 < 2; ++s2) { xb[s2].x = cvt_pk_bf16(X[2 * s2][0], X[2 * s2][1]); xb[s2].y = cvt_pk_bf16(X[2 * s2][2], X[2 * s2][3]); xb[s2].z = cvt_pk_bf16(X[2 * s2 + 1][0], X[2 * s2 + 1][1]); xb[s2].w = cvt_pk_bf16(X[2 * s2 + 1][2], X[2 * s2 + 1][3]);
                *(GAS u32x2*)(XTB + (size_t)n * 4096 + 32 * s2) = (u32x2){xb[s2].x, xb[s2].y}; *(GAS u32x2*)(XTB + (size_t)n * 4096 + 32 * s2 + 16) = (u32x2){xb[s2].z, xb[s2].w}; }
#pragma unroll
            for (int kt = 0; kt < 4; ++kt) { f32x4 a = S[kt] + cvk[kt];
#pragma unroll
                for (int s2 = 0; s2 < 2; ++s2) a = __builtin_amdgcn_mfma_f32_16x16x32_bf16(__builtin_bit_cast(bf16x8, cbf[kt * 2 + s2]), __builtin_bit_cast(bf16x8, xb[s2]), a, 0, 0, 0);
                S[kt] = a * cpl[kt]; }
            asm volatile("s_waitcnt lgkmcnt(0)" ::: "memory");
            RW2_BAR();
        }
    }
#undef RW2_BAR
}
__device__ __forceinline__ void rw3_phase(const Ctx& c0, int l) { const Ctx c = fresh(c0);
    GAS unsigned char* ws = wsp(c); const int half = c.wave >> 2, wl = c.wave & 3, ht = c.tid & 255, lane = c.lane, l15 = lane & 15, q = lane >> 4;
    LAS bf16* sR = (LAS bf16*)c.lds + half * 4 * 64 * RP2; LAS bf16* sA2 = sR + 64 * RP2; LAS bf16* sS0 = sA2 + 64 * RP2; LAS bf16* sXT = sS0 + 64 * RP2;
    const GAS float* ng = inp(c, 24) + l * 1024; const GAS float* nb = inp(c, 25) + l * 1024;
    const GAS bf16* BV = (const GAS bf16*)(ws + WS_RW); const GAS bf16* GG = (const GAS bf16*)(ws + WS_GG); GAS bf16* O = (GAS bf16*)(ws + WS_ORWKV);
    u32x4 pf[8];
#define RW3_FETCH(rec_) do { _Pragma("unroll") for (int e = 0; e < 2; ++e) { const int idx = ht + 256 * e, row = idx >> 3, c8 = idx & 7; const size_t go = (size_t)(rec_) * 4096 + row * 64 + c8 * 8; \
        pf[4 * e] = *(const GAS u32x4*)((const GAS bf16*)(ws + WS_RT) + go); pf[4 * e + 1] = *(const GAS u32x4*)((const GAS bf16*)(ws + WS_ARBT) + go); \
        pf[4 * e + 2] = *(const GAS u32x4*)((const GAS bf16*)(ws + WS_S0B) + go); pf[4 * e + 3] = *(const GAS u32x4*)((const GAS bf16*)(ws + WS_XTB) + go); } } while (0)
    if (c.bx * 2 < 2048) { const int it0 = c.bx * 2 + half; RW3_FETCH((it0 >> 7) * 128 + (it0 & 127)); }
    for (int base = c.bx * 2; base < 2048; base += 2 * c.G) { const int it = base + half, h = it >> 7, n = it & 127; const size_t rec = (size_t)(h * 128 + n);
        const GAS bf16* y0 = (const GAS bf16*)(ws + WS_Y0) + rec * 4096; const int trow = 16 * wl + l15;
        u32x2 yv[4], bvv[4], ggv[4]; f32x4 ngv[4], nbv[4];
#pragma unroll
        for (int vt = 0; vt < 4; ++vt) { yv[vt] = *(const GAS u32x2*)(y0 + trow * 64 + 16 * vt + 4 * q);
            const int col = 64 * h + 16 * vt + 4 * q; const size_t o = (size_t)(64 * n + trow) * 1024 + col;
            bvv[vt] = *(const GAS u32x2*)(BV + o); ggv[vt] = *(const GAS u32x2*)(GG + o); ngv[vt] = *(const GAS f32x4*)(ng + col); nbv[vt] = *(const GAS f32x4*)(nb + col); }
#pragma unroll
        for (int e = 0; e < 2; ++e) { const int idx = ht + 256 * e, row = idx >> 3, c8 = idx & 7, lo = row * RP2 + c8 * 8;
            *(LAS u32x4*)(sR + lo) = pf[4 * e]; *(LAS u32x4*)(sA2 + lo) = pf[4 * e + 1]; *(LAS u32x4*)(sS0 + lo) = pf[4 * e + 2]; *(LAS u32x4*)(sXT + lo) = pf[4 * e + 3]; }
        __syncthreads();
        if (base + 2 * c.G < 2048) { const int itn = base + 2 * c.G + half; RW3_FETCH((itn >> 7) * 128 + (itn & 127)); }
        f32x4 acc[4];
#pragma unroll
        for (int vt = 0; vt < 4; ++vt) { const u32x2 y = yv[vt]; acc[vt] = (f32x4){bf_lo(y.x), bf_hi(y.x), bf_lo(y.y), bf_hi(y.y)};
            acc[vt] = mm16<true>(acc[vt], sR + 16 * wl * RP2, sS0 + 16 * vt * RP2, lane); acc[vt] = mm16<true>(acc[vt], sA2 + 16 * wl * RP2, sXT + 16 * vt * RP2, lane); }
        { const int t = 64 * n + trow; const f32x4 s4 = (acc[0] + acc[1]) + (acc[2] + acc[3]);
          float s1 = (s4[0] + s4[1]) + (s4[2] + s4[3]); s1 += __shfl_xor(s1, 16); s1 += __shfl_xor(s1, 32);
          const float mean = s1 * (1.f / 64.f); f32x4 q4 = (f32x4){0.f, 0.f, 0.f, 0.f};
#pragma unroll
          for (int vt = 0; vt < 4; ++vt) { const f32x4 d = acc[vt] - mean; q4 = q4 + d * d; }
          float qv = (q4[0] + q4[1]) + (q4[2] + q4[3]); qv += __shfl_xor(qv, 16); qv += __shfl_xor(qv, 32);
          const float rstd = rsq(qv * (1.f / 64.f) + RWKV_GN_EPS);
#pragma unroll
          for (int vt = 0; vt < 4; ++vt) { const int col = 64 * h + 16 * vt + 4 * q; const size_t o = (size_t)t * 1024 + col;
              const u32x2 bv = bvv[vt], gg = ggv[vt];
              const f32x4 bv4 = (f32x4){bf_lo(bv.x), bf_hi(bv.x), bf_lo(bv.y), bf_hi(bv.y)}, gg4 = (f32x4){bf_lo(gg.x), bf_hi(gg.x), bf_lo(gg.y), bf_hi(gg.y)};
              const f32x4 v = ((acc[vt] - mean) * rstd * ngv[vt] + nbv[vt] + bv4) * gg4;
              u32x2 ob; ob.x = cvt_pk_bf16(v[0], v[1]); ob.y = cvt_pk_bf16(v[2], v[3]); *(GAS u32x2*)(O + o) = ob; } }
        __syncthreads(); }
#undef RW3_FETCH
}
__device__ __forceinline__ void ln_phase(const Ctx& c0, const GAS bf16* VH, const GAS bf16* VLo, const GAS float* gam, const GAS float* bet, GAS float* OF) { const Ctx c = fresh(c0);
    f32x4 gmv[8], btv[8];
#pragma unroll
    for (int j = 0; j < 8; ++j) { const int col = (c.lane + 64 * j) * 4; gmv[j] = *(const GAS f32x4*)(gam + col); btv[j] = *(const GAS f32x4*)(bet + col); }
    for (int t0 = c.gw; t0 < T; t0 += 2 * c.NGW) {
        u32x2 ra[2][8], rb[2][8];
#pragma unroll
        for (int k = 0; k < 2; ++k) { const int t = t0 + k * c.NGW; if (t < T) { const GAS u32x2* rh = (const GAS u32x2*)(VH + (size_t)t * D) + c.lane; const GAS u32x2* rl = (const GAS u32x2*)(VLo + (size_t)t * D) + c.lane;
#pragma unroll
            for (int j = 0; j < 8; ++j) { ra[k][j] = rh[64 * j]; rb[k][j] = RESID_LO ? rl[64 * j] : (u32x2){0u, 0u}; } } }
#pragma unroll
        for (int k = 0; k < 2; ++k) { const int t = t0 + k * c.NGW; if (t < T) { f32x4 v[8]; float s = 0.f;
#pragma unroll
            for (int j = 0; j < 8; ++j) { const u32x2 a = ra[k][j], b = rb[k][j]; v[j] = (f32x4){bf_lo(a.x) + bf_lo(b.x), bf_hi(a.x) + bf_hi(b.x), bf_lo(a.y) + bf_lo(b.y), bf_hi(a.y) + bf_hi(b.y)}; s += (v[j][0] + v[j][1]) + (v[j][2] + v[j][3]); }
            const float mean = wave_sum(s) * (1.f / D); float q = 0.f;
#pragma unroll
            for (int j = 0; j < 8; ++j) { v[j] = v[j] - mean; q += (v[j][0] * v[j][0] + v[j][1] * v[j][1]) + (v[j][2] * v[j][2] + v[j][3] * v[j][3]); }
            const float rstd = rsq(wave_sum(q) * (1.f / D) + LN_EPS);
#pragma unroll
            for (int j = 0; j < 8; ++j) { const int col = (c.lane + 64 * j) * 4; const f32x4 o = v[j] * rstd * gmv[j] + btv[j];
                *(GAS f32x4*)(OF + (size_t)t * D + col) = o; } } } }
}
__device__ __forceinline__ void conv_phase(const Ctx& c0, int l) { const Ctx c = fresh(c0);
    const GAS bf16* H = (const GAS bf16*)(wsp(c) + WS_H); GAS bf16* HA = (GAS bf16*)(wsp(c) + WS_HACT); const GAS float* wc = inp(c, 31) + (size_t)l * 3 * 11264;
    for (int idx = c.bx * 512 + c.tid; idx < T * 704; idx += c.G * 512) { const int t = idx / 704, c8 = idx % 704, co = c8 * 8, hc = (co >> 7) * 256 + (co & 127);
        f32x4 a0 = (f32x4){0.f, 0.f, 0.f, 0.f}, a1 = a0, b0 = a0, b1 = a0;
#pragma unroll
        for (int j = 0; j < 3; ++j) { const int tt = t - 2 + j; if (tt >= 0) { f32x4 x0, x1, y0, y1;
                unpack8(*(const GAS u32x4*)(H + (size_t)tt * 11264 + hc), x0, x1); unpack8(*(const GAS u32x4*)(H + (size_t)tt * 11264 + hc + 128), y0, y1);
                const GAS float* wa = wc + j * 11264 + co; const GAS float* wb = wa + 5632;
                a0 += x0 * *(const GAS f32x4*)wa; a1 += x1 * *(const GAS f32x4*)(wa + 4); b0 += y0 * *(const GAS f32x4*)wb; b1 += y1 * *(const GAS f32x4*)(wb + 4); } }
        *(GAS u32x4*)(HA + (size_t)t * DFF + co) = pack8(a0 * sigm4(a0) * b0, a1 * sigm4(a1) * b1); }
}

#ifndef MK_SPLIT
#define MK_SPLIT 0
#endif
constexpr int NPH_LAYER = 10, NPH = 2 + DEPTH * NPH_LAYER + 1;
struct Args { const float* in[35]; float* out; unsigned char* ws; int ph_lo, ph_hi; };

__global__ void __launch_bounds__(NWAVES * 64, 2) fwd(Args args) {
    extern __shared__ __attribute__((aligned(16))) unsigned char lds_raw[];
    Ctx c;
    c.lds = (LAS unsigned char*)(unsigned)LDS_BASE; (void)lds_raw;
    c.wave = __builtin_amdgcn_readfirstlane((int)threadIdx.x >> 6); c.lane = lane_id_now(); c.tid = c.wave * 64 + c.lane;
    c.G = gridDim.x; c.bx = blockIdx.x; { const int bx = blockIdx.x; c.vcu = (c.G % 8 == 0) ? (bx % 8) * (c.G / 8) + bx / 8 : bx; }
    c.gw = c.vcu * NWAVES + c.wave; c.NGW = c.G * NWAVES;
    volatile LAS unsigned* MISC = (volatile LAS unsigned*)(unsigned)(LDS_BASE + MISC_OFF);
    for (int u = c.tid; u < (LDS_BYTES - LDS_BASE - LDSCTL_OFF) / 4; u += NWAVES * 64) ((LAS unsigned*)(c.lds + LDSCTL_OFF))[u] = 0u;
    __syncthreads();
    { LAS unsigned long long* tab = (LAS unsigned long long*)(unsigned)(LDS_BASE + PTAB_OFF);
#pragma unroll
      for (int i = 0; i < 35; ++i) if (c.tid == i) tab[i] = (unsigned long long)args.in[i];
      if (c.tid == 35) tab[35] = (unsigned long long)args.ws;
      if (c.tid == 36) tab[36] = (unsigned long long)args.out; }
    __syncthreads();
#if MK_SPLIT
    const int lo = args.ph_lo, hi = args.ph_hi;
#else
    constexpr int lo = 0, hi = NPH;
#endif
    if (hi - lo > 1) { const XcdBarrier b0 = xcd_barrier_post((unsigned*)(args.ws + WS_CTL) + CW_BAR, MISC + 8); if (c.tid == 0) MISC[10] = b0.x; }
    __syncthreads();
#define IN(k) (lo <= (k) && (k) < hi)
#define SEAM(k) do { if ((k) + 1 < hi) { XcdBarrier b_; b_.bar = (unsigned*)((GAS unsigned*)(wsp(c) + WS_CTL) + CW_BAR); b_.x = __builtin_amdgcn_readfirstlane(MISC[10]); b_.st = MISC + 8; xcd_barrier(b_); } } while (0)
    LAS unsigned char* ring = c.lds;
    const int bx0 = blockIdx.x;
#define CONV_SLOT(nunits, Gs, cidx, p0, p1) do { if (DEFER_CONV && l + 1 < DEPTH) { const int first_ = (nunits) % (Gs); if ((cidx) >= first_) { __syncthreads(); conv_items<3>(c, l + 1, (p0), (p1), ((cidx) - first_) * NWAVES + c.wave, ((Gs) - first_) * NWAVES); } } } while (0)

    if (IN(0)) { prologue(c); SEAM(0); }
    if (IN(1)) { c12_reduce(c, 0, DEFER_CONV ? 1 : DEPTH); SEAM(1); }

    for (int lay = 0; lay < DEPTH; ++lay) {
        const int pb = 2 + lay * NPH_LAYER;
        if (IN(pb + 0)) { int l = lay, bx = bx0; asm volatile("" : "+s"(l), "+s"(bx));
            PRB(0) { const GAS bf16* XBp = (const GAS bf16*)(wsp(c) + WS_XB); const GAS bf16* WINp = (const GAS bf16*)(wsp(c) + WS_WIN) + (size_t)l * NIN * D; const GAS float* C12p = (const GAS float*)(wsp(c) + WS_C12) + (size_t)l * C12_STRIDE;
              pg8::Gemm g{XBp, WINp, D, D, D, 256, WINp + (size_t)2048 * D, XBp};
              DualOrder<ProjOrder, pg8::StaticOrder> S; S.a.init(32, 53, 1, 0); S.b.init(8, 32, 1, 0); S.n0 = 32 * 53; S.G = c.G; S.c = bx;
              EpiProjAll E{EpiProj{(GAS bf16*)(wsp(c) + WS_U2), (GAS bf16*)(wsp(c) + WS_RQ), (GAS bf16*)(wsp(c) + WS_RK), (GAS bf16*)(wsp(c) + WS_RG), (GAS bf16*)(wsp(c) + WS_ZR), (GAS bf16*)(wsp(c) + WS_GATES),
                                   (const GAS float*)(wsp(c) + WS_ROPE), (const GAS float*)(wsp(c) + WS_ROPE) + T * 64, (const GAS float*)(wsp(c) + WS_STATS2), C12p, C12p + NIN},
                           EpiProjT{(GAS bf16*)(wsp(c) + WS_RKT), (GAS bf16*)(wsp(c) + WS_RVT), (const GAS float*)(wsp(c) + WS_ROPE) + 2 * T * 64, (const GAS float*)(wsp(c) + WS_ROPE) + 3 * T * 64, (const GAS float*)(wsp(c) + WS_STATS2), C12p + 2048, C12p + NIN + 2048}};
              pg8::gemm_phase<EpiProjAll, DualOrder<ProjOrder, pg8::StaticOrder>, true>(ring, g, S, E, c.wave); }
            CONV_SLOT(32 * 53 + 8 * 32, c.G, bx, 0, CONV_B1);
            SEAM(pb + 0);
        }
        if (IN(pb + 1)) { int l = lay, bx = bx0; asm volatile("" : "+s"(l), "+s"(bx));
            PRB(10) { pg8::Gemm g{(const GAS bf16*)(wsp(c) + WS_U2), (const GAS bf16*)(wsp(c) + WS_MST) + (size_t)l * 64 * 65536, 384, 256, 256};
              GroupOrder S{c.G, bx}; EpiS1 E{(GAS float*)(wsp(c) + WS_SLOC)};
              pg8::gemm_phase<EpiS1, GroupOrder, true>(ring, g, S, E, c.wave); }
            PRB(11) ret_kv_phase(c);
            PRB(12) rwkv_a_phase(c, l);
            { GAS long long* z1 = (GAS long long*)(wsp(c) + WS_STATS1); if (bx < T * 2 / 512) { long long zz = 0ll; asm volatile("" : "+v"(zz)); z1[bx * 512 + c.wave * 64 + lane_id_now()] = zz; } }
            SEAM(pb + 1);
        }
        if (IN(pb + 2)) { int l = lay, bx = bx0; asm volatile("" : "+s"(l), "+s"(bx));
            PRB(20) ssm_scan(c, l);
            PRB(21) ret_scan_phase(c);
            PRB(22) { pg8::Gemm g{(const GAS bf16*)(wsp(c) + WS_ALR), (const GAS bf16*)(wsp(c) + WS_WLR) + (size_t)l * 3072 * 256, 256, 256, 256};
              pg8::StaticOrder S; S.init(32, 12, c.G, bx);
              EpiLR E{(GAS float*)(wsp(c) + WS_DEC), inp(c, 16) + l * 1024, inp(c, 18) + l * 1024};
              pg8::gemm_phase<EpiLR, pg8::StaticOrder, true>(ring, g, S, E, c.wave); }
            SEAM(pb + 2);
        }
        if (IN(pb + 3)) { int l = lay, bx = bx0; asm volatile("" : "+s"(l), "+s"(bx));
            PRB(30) { pg8::Gemm g{(const GAS bf16*)(wsp(c) + WS_U2), (const GAS bf16*)(wsp(c) + WS_MIC) + (size_t)l * 64 * 98304, 384, 384, 384};
              GroupOrder S{c.G, bx}; EpiS3 E{(const GAS bf16*)(wsp(c) + WS_U2), (GAS bf16*)(wsp(c) + WS_Z), inp(c, 10) + l * 1024};
              pg8::gemm_phase<EpiS3, GroupOrder, true>(ring, g, S, E, c.wave); }
            PRB(31) ret_out_phase(c, l);
            PRB(41) rw1_phase(c, l);
            SEAM(pb + 3);
        }
        if (IN(pb + 4)) { int l = lay, bx = bx0; asm volatile("" : "+s"(l), "+s"(bx));
            if (bx < 16) { PRB(50) rw2_phase(c); }
            else { pg8::Gemm g{(const GAS bf16*)(wsp(c) + WS_ORET), (const GAS bf16*)(wsp(c) + WS_WRET) + (size_t)l * 2048 * 1024, 1024, 1024, 1024, 256, (const GAS bf16*)(wsp(c) + WS_Z), (const GAS bf16*)(wsp(c) + WS_WGLU) + (size_t)l * 4096 * 1024};
              DualOrder<pg8::StaticOrder, pg8::StaticOrder> S; S.a.init(32, 8, 1, 0); S.b.init(32, 16, 1, 0); S.n0 = 256; S.G = c.G - 16; S.c = bx - 16;
              EpiMerge01 E{EpiMerge<0>{(GAS bf16*)(wsp(c) + WS_MERGED), (GAS bf16*)(wsp(c) + WS_M1), (GAS bf16*)(wsp(c) + WS_MERGEDB), (const GAS bf16*)(wsp(c) + WS_GATES)},
                           EpiMerge<1>{(GAS bf16*)(wsp(c) + WS_MERGED), (GAS bf16*)(wsp(c) + WS_M1), (GAS bf16*)(wsp(c) + WS_MERGEDB), (const GAS bf16*)(wsp(c) + WS_GATES)}};
              pg8::gemm_phase<EpiMerge01, DualOrder<pg8::StaticOrder, pg8::StaticOrder>, true>(ring, g, S, E, c.wave);
              CONV_SLOT(32 * 8 + 32 * 16, c.G - 16, bx - 16, CONV_B1, CONV_B2); }
            SEAM(pb + 4);
        }
        if (IN(pb + 5)) { int l = lay, bx = bx0; asm volatile("" : "+s"(l), "+s"(bx)); PRB(60) rw3_phase(c, l); SEAM(pb + 5); }
        if (IN(pb + 6)) { int l = lay, bx = bx0; asm volatile("" : "+s"(l), "+s"(bx));
            PRB(70) { pg8::Gemm g{(const GAS bf16*)(wsp(c) + WS_ORWKV), (const GAS bf16*)(wsp(c) + WS_WRWKV) + (size_t)l * 2048 * 1024, 1024, 1024, 1024};
              pg8::StaticOrder S; S.init(32, 8, c.G, bx); EpiMerge<2> E{(GAS bf16*)(wsp(c) + WS_MERGED), (GAS bf16*)(wsp(c) + WS_M1), (GAS bf16*)(wsp(c) + WS_MERGEDB), (const GAS bf16*)(wsp(c) + WS_GATES)};
              pg8::gemm_phase<EpiMerge<2>, pg8::StaticOrder, true>(ring, g, S, E, c.wave); }
            SEAM(pb + 6);
        }
        if (IN(pb + 7)) { int l = lay, bx = bx0; asm volatile("" : "+s"(l), "+s"(bx));
            PRB(80) { pg8::Gemm g{(const GAS bf16*)(wsp(c) + WS_MERGEDB), (const GAS bf16*)(wsp(c) + WS_WO) + (size_t)l * 2048 * 2048, 2048, 2048, 2048};
              pg8::StaticOrder S; S.init(32, 8, c.G, bx);
              EpiResidStats E{inp(c, 0), (const GAS bf16*)(wsp(c) + WS_XB), (const GAS bf16*)(wsp(c) + WS_XF), (l == 0) ? (const GAS float*)nullptr : (const GAS float*)(wsp(c) + WS_STATS2), inp(c, 33) + (size_t)(l == 0 ? 0 : l - 1) * D, inp(c, 34) + (size_t)(l == 0 ? 0 : l - 1) * D,
                              (GAS bf16*)(wsp(c) + WS_X1B) + 2 * D, (GAS bf16*)(wsp(c) + WS_X1F), (GAS float*)(wsp(c) + WS_STATS1)};
              pg8::gemm_phase<EpiResidStats, pg8::StaticOrder, true>(ring, g, S, E, c.wave); }
            SEAM(pb + 7);
        }
        if (IN(pb + 8)) { int l = lay, bx = bx0; asm volatile("" : "+s"(l), "+s"(bx));
            PRB(90) { pg8::Gemm g{(const GAS bf16*)(wsp(c) + WS_X1B), (const GAS bf16*)(wsp(c) + WS_WUP) + (size_t)l * 11264 * 2048, 2048, 2048, 2048, 254};
              pg8::StaticOrder S; S.init(33, 44, c.G, bx);
              EpiUpConv E{(GAS bf16*)(wsp(c) + WS_HACT), (const GAS float*)(wsp(c) + WS_STATS1), (const GAS float*)(wsp(c) + WS_C12) + (size_t)l * C12_STRIDE + 2 * NIN, (const GAS float*)(wsp(c) + WS_C12) + (size_t)l * C12_STRIDE + 2 * NIN + 11264,
                          inp(c, 31) + (size_t)l * 3 * 11264, ring};
              pg8::gemm_phase<EpiUpConv, pg8::StaticOrder, true>(ring, g, S, E, c.wave); }
            { GAS long long* z2 = (GAS long long*)(wsp(c) + WS_STATS2); if (bx < T * 2 / 512) { long long zz = 0ll; asm volatile("" : "+v"(zz)); z2[bx * 512 + c.wave * 64 + lane_id_now()] = zz; } }
            CONV_SLOT(33 * 44, c.G, bx, CONV_B2, CONV_B3);
            SEAM(pb + 8);
        }
        if (IN(pb + 9)) { int l = lay, bx = bx0; asm volatile("" : "+s"(l), "+s"(bx));
            if (DEFER_CONV && l + 1 < DEPTH) c12_reduce(c, l + 1, l + 2);
            PRB(100) { pg8::Gemm g{(const GAS bf16*)(wsp(c) + WS_HACT), (const GAS bf16*)(wsp(c) + WS_WDOWN) + (size_t)l * 2048 * 5632, 5632, 5632, 5632};
              pg8::StaticOrder S; S.init(32, 8, c.G, bx);
              EpiResidStats E{inp(c, 0), (const GAS bf16*)(wsp(c) + WS_X1B) + 2 * D, (const GAS bf16*)(wsp(c) + WS_X1F), (const GAS float*)(wsp(c) + WS_STATS1), inp(c, 28) + (size_t)l * D, inp(c, 29) + (size_t)l * D,
                              (GAS bf16*)(wsp(c) + WS_XB), (GAS bf16*)(wsp(c) + WS_XF), (GAS float*)(wsp(c) + WS_STATS2)};
              pg8::gemm_phase<EpiResidStats, pg8::StaticOrder, true>(ring, g, S, E, c.wave); }
            SEAM(pb + 9);
        }
    }
    if (IN(NPH - 1)) { ln_phase(c, (const GAS bf16*)(wsp(c) + WS_XB), (const GAS bf16*)(wsp(c) + WS_XF), inp(c, 33) + (size_t)(DEPTH - 1) * D, inp(c, 34) + (size_t)(DEPTH - 1) * D, outp(c)); }
#undef IN
#undef SEAM
#undef CONV_SLOT
}

extern "C" void kernel_launch(void* const* d_in, const int* in_sizes, int n_in, void* d_out, int out_size, void* d_ws, size_t ws_size, hipStream_t stream) {
    static int grid = 0;
    if (grid == 0) {
        if (n_in != 35 || out_size != T * D || ws_size < WS_END) { fprintf(stderr, "kernel_launch: unexpected problem: n_in %d out %d ws %zu (need %zu)\n", n_in, out_size, ws_size, (size_t)WS_END); grid = -1; return; }
        int dev = 0, cus = 0, per_cu = 0;
        if (hipGetDevice(&dev) != hipSuccess || hipDeviceGetAttribute(&cus, hipDeviceAttributeMultiprocessorCount, dev) != hipSuccess) { grid = -1; return; }
        if (hipFuncSetAttribute((const void*)fwd, hipFuncAttributeMaxDynamicSharedMemorySize, LDS_BYTES) != hipSuccess) { fprintf(stderr, "kernel_launch: hipFuncSetAttribute failed\n"); grid = -1; return; }
        if (hipOccupancyMaxActiveBlocksPerMultiprocessor(&per_cu, (const void*)fwd, NWAVES * 64, LDS_BYTES) != hipSuccess || per_cu < 1) fprintf(stderr, "kernel_launch: occupancy query reports %d\n", per_cu);
        (void)hipGetLastError();
        grid = cus;
    }
    if (grid < 0) return;
    if (hipMemsetAsync((char*)d_ws + WS_CTL, 0, CTL_ZERO_BYTES, stream) != hipSuccess) return;
    Args a{};
    for (int i = 0; i < 35; ++i) a.in[i] = (const float*)d_in[i];
    a.out = (float*)d_out; a.ws = (unsigned char*)d_ws;
#if MK_SPLIT
    for (int p = 0; p < NPH; ++p) { a.ph_lo = p; a.ph_hi = p + 1; hipLaunchKernelGGL(fwd, dim3(grid), dim3(NWAVES * 64), LDS_BYTES, stream, a); }
#else
    a.ph_lo = 0; a.ph_hi = NPH;
    hipLaunchKernelGGL(fwd, dim3(grid), dim3(NWAVES * 64), LDS_BYTES, stream, a);
#endif
}
```

```cpp
#include <hip/hip_runtime.h>
#include <cstdio>
#include <cstdint>

#define GAS __attribute__((address_space(1)))
#define LAS __attribute__((address_space(3)))
#ifndef RESID_LO
#define RESID_LO 0
#endif
typedef unsigned short bf16;
typedef short bf16x8 __attribute__((ext_vector_type(8)));
typedef float f32x4 __attribute__((ext_vector_type(4)));
typedef float f32x2 __attribute__((ext_vector_type(2)));
typedef unsigned u32x4 __attribute__((ext_vector_type(4)));
typedef unsigned u32x2 __attribute__((ext_vector_type(2)));

constexpr int T = 8192, D = 2048, DEPTH = 4;
constexpr int NIN = 14592, OFF_RET = 1024, OFF_RWKV = 5120, OFF_GATE = 8448;
constexpr int RWKV_IN = 3328, DFF = 5632;
constexpr float DN_ALPHA = 1.6817928305074290f;
constexpr float LN_EPS = 1e-5f, GN_EPS = 1e-5f, RWKV_GN_EPS = 64e-5f;

__device__ __forceinline__ float bf_lo(unsigned u) { return __uint_as_float(u << 16); }
__device__ __forceinline__ float bf_hi(unsigned u) { return __uint_as_float(u & 0xffff0000u); }
__device__ __forceinline__ float bf2f(bf16 b) { return __uint_as_float(((unsigned)b) << 16); }
typedef __bf16 bf16x2v __attribute__((ext_vector_type(2)));
__device__ __forceinline__ unsigned cvt_pk_bf16(float lo, float hi) { return __builtin_bit_cast(unsigned, __builtin_convertvector((f32x2){lo, hi}, bf16x2v)); }
__device__ __forceinline__ bf16 f2bf(float f) { return (bf16)(cvt_pk_bf16(f, 0.f) & 0xffffu); }
__device__ __forceinline__ u32x4 pack8(const f32x4 a, const f32x4 b) { u32x4 w; w.x = cvt_pk_bf16(a[0], a[1]); w.y = cvt_pk_bf16(a[2], a[3]); w.z = cvt_pk_bf16(b[0], b[1]); w.w = cvt_pk_bf16(b[2], b[3]); return w; }
__device__ __forceinline__ void unpack8(const u32x4 w, f32x4& a, f32x4& b) { a = (f32x4){bf_lo(w.x), bf_hi(w.x), bf_lo(w.y), bf_hi(w.y)}; b = (f32x4){bf_lo(w.z), bf_hi(w.z), bf_lo(w.w), bf_hi(w.w)}; }
__device__ __forceinline__ float sigm(float x) { return __builtin_amdgcn_rcpf(1.f + __expf(-x)); }
__device__ __forceinline__ f32x4 sigm4(f32x4 x) { return (f32x4){sigm(x[0]), sigm(x[1]), sigm(x[2]), sigm(x[3])}; }
__device__ __forceinline__ float gelu_tanh(float y) { const float z = 1.5957691216057308f * (y + 0.044715f * y * y * y); return y * sigm(z); }
__device__ __forceinline__ float ex2(float x) { return __builtin_amdgcn_exp2f(x); }
__device__ __forceinline__ float l2gamma(int h) {
    return h == 0 ? -0.04580368961312479f : h == 1 ? -0.02272007650008353f : h == 2 ? -0.011315313227834146f : h == 3 ? -0.005646563141142063f
         : h == 4 ? -0.0028205190623786626f : h == 5 ? -0.0014095702546713536f : h == 6 ? -0.0007046129765893727f : -0.0003522634716290214f;
}
__device__ __forceinline__ void sincos_cw(float x, float& sn, float& cs) {
    const float n = rintf(x * 0.6366197723675814f);
    float r = fmaf(-n, 1.570796251296997f, x); r = fmaf(-n, 7.549790126404332e-08f, r);
    const float r2 = r * r;
    const float sp = r + r * r2 * (-1.6666654611e-1f + r2 * (8.3321608736e-3f + r2 * (-1.9515295891e-4f)));
    const float cp = 1.f - 0.5f * r2 + r2 * r2 * (4.166664568298827e-2f + r2 * (-1.388731625493765e-3f + r2 * 2.443315711809948e-5f));
    const int q = (int)n & 3;
    sn = (q == 0) ? sp : (q == 1) ? cp : (q == 2) ? -sp : -cp;
    cs = (q == 0) ? cp : (q == 1) ? -sp : (q == 2) ? -cp : sp;
}
__device__ __forceinline__ float rsq(float x) { return __builtin_amdgcn_rsqf(x); }
__device__ __forceinline__ float softplus_f(float x) { return fmaxf(x, 0.f) + __logf(1.f + __expf(-fabsf(x))); }

namespace pg8 {
constexpr int BM = 256, BK = 64, HALF = 128, HTB = HALF * BK * 2, STAGE_BYTES = 8 * HTB, NXCD = 8, WGM = 8;
__host__ __device__ __forceinline__ int lds_byte(int r, int c) { const int st = (r >> 4) * 2 + (c >> 5), rr = r & 15, cc = c & 31, ob = rr * 64 + cc * 2; return st * 1024 + (ob ^ (((ob >> 9) & 1) << 5)); }
__host__ __device__ __forceinline__ void stage_rc(int b, int& R, int& C) { const int st = b / 1024, sb = b % 1024, swz = sb ^ (((sb >> 9) & 1) << 5); R = (st >> 1) * 16 + swz / 64; C = (st & 1) * 32 + (swz % 64) / 2; }
__host__ __device__ __forceinline__ int perm32(int rho) { const int n = rho >> 4, i = rho & 15; return 8 * (i >> 2) + 4 * n + (i & 3); }

struct Unit { int pm, pn, kind; };
struct Gemm { const GAS bf16* A; const GAS bf16* Bt; int lda, ldb, K; int mstep = 256; const GAS bf16* A2 = nullptr; const GAS bf16* Bt2 = nullptr; };

struct StaticOrder {
    int nM, nN, nwg, G, c;
    __device__ void init(int nM_, int nN_, int G_, int c_) { nM = nM_; nN = nN_; nwg = nM * nN; G = G_; c = c_; }
    __device__ bool next(int i, Unit& u) const {
        const long L = (long)i * G + c; if (L >= nwg) return false;
        int wgid = (int)L; { const int q = nwg / NXCD, r = nwg % NXCD, xcd = wgid % NXCD, off = wgid / NXCD; wgid = (xcd < r ? xcd * (q + 1) : r * (q + 1) + (xcd - r) * q) + off; }
        const int nig = WGM * nN, gid = wgid / nig, fm = gid * WGM, gsz = (nM - fm) < WGM ? (nM - fm) : WGM;
        u.pm = fm + ((wgid % nig) % gsz); u.pn = (wgid % nig) / gsz; u.kind = 0; return true;
    }
};
template <class Epi, class Sched, bool ALIGN_EPI>
__device__ __forceinline__ void gemm_phase(LAS unsigned char* lds, const Gemm g, const Sched& S, const Epi& E, int wave_id) {
    int wid_ = wave_id; asm volatile("" : "+s"(wid_)); int lane_; asm volatile("v_mbcnt_lo_u32_b32 %0, -1, 0\n\tv_mbcnt_hi_u32_b32 %0, -1, %0" : "=v"(lane_));
    const int wid = wid_, lane = lane_, tid = wid * 64 + lane, wr = wid >> 2, wc = wid & 3, fr = lane & 15, fq = lane >> 4;
    const int K = g.K, nt = K / BK;
    unsigned voffA[2], voffB[2];
#pragma unroll
    for (int i = 0; i < 2; ++i) { int R, C; stage_rc(tid * 16 + i * 8192, R, C); const int Rb = (R & ~31) + perm32(R & 31);
        voffA[i] = (unsigned)(R * g.lda + C) * 2u; voffB[i] = (unsigned)(Rb * g.ldb + C) * 2u; }
    const size_t kstep = (size_t)(BK * 2);
    const size_t hsA = (size_t)HALF * g.lda * 2, hsB = (size_t)HALF * g.ldb * 2;
    const size_t tsA = (size_t)g.mstep * g.lda * 2, tsB = 2 * hsB;
    const unsigned ldsw = (unsigned)wid * 1024u;
    const int aoff = lds_byte(wr * 64 + fr, fq * 8), boff = lds_byte(wc * 32 + fr, fq * 8);
#define PG8_SA(b, h) (((b) * 2 + (h)) * HTB)
#define PG8_SB(b, h) ((4 + (b) * 2 + (h)) * HTB)
#define PG8_STAGE(bufoff, gbase, voff) do { _Pragma("unroll") for (int _i = 0; _i < 2; ++_i) \
        __builtin_amdgcn_global_load_lds((const GAS unsigned*)((const GAS char*)(gbase) + (voff)[_i]), (LAS unsigned*)(lds + (bufoff) + ldsw + _i * 8192), 16, 0, 0); } while (0)
#define PG8_LDA(dst, b, h) do { _Pragma("unroll") for (int m = 0; m < 4; ++m) _Pragma("unroll") for (int k = 0; k < 2; ++k) dst[m][k] = *(const LAS bf16x8*)(lds + PG8_SA(b, h) + aoff + m * 2048 + k * 1024); } while (0)
#define PG8_LDB(dst, b, h) do { _Pragma("unroll") for (int n = 0; n < 2; ++n) _Pragma("unroll") for (int k = 0; k < 2; ++k) dst[n][k] = *(const LAS bf16x8*)(lds + PG8_SB(b, h) + boff + n * 2048 + k * 1024); } while (0)
#define PG8_MMA(ai, bj, At, Bt) do { __builtin_amdgcn_s_setprio(1); _Pragma("unroll") for (int m = 0; m < 4; ++m) _Pragma("unroll") for (int n = 0; n < 2; ++n) _Pragma("unroll") for (int k = 0; k < 2; ++k) \
        acc[ai][bj][m][n] = __builtin_amdgcn_mfma_f32_16x16x32_bf16(Bt[n][k], At[m][k], acc[ai][bj][m][n], 0, 0, 0); __builtin_amdgcn_s_setprio(0); } while (0)
#define PG8_WAIT_V(n) asm volatile("s_waitcnt vmcnt(" #n ")" ::: "memory")
#define PG8_WAIT_L(n) asm volatile("s_waitcnt lgkmcnt(" #n ")" ::: "memory")
#define PG8_BAR __builtin_amdgcn_s_barrier()
#define PG8_SCHED __builtin_amdgcn_sched_barrier(0)
    Unit cur, nxt; int ui = 0;
    if (!S.next(0, cur)) return;
    f32x4 acc[2][2][4][2];
#pragma unroll
    for (int a = 0; a < 2; ++a)
#pragma unroll
        for (int b = 0; b < 2; ++b)
#pragma unroll
            for (int m = 0; m < 4; ++m)
#pragma unroll
                for (int n = 0; n < 2; ++n) acc[a][b][m][n] = (f32x4){0.f, 0.f, 0.f, 0.f};
    bf16x8 At[4][2], B0[2][2], B1[2][2];
    const GAS char* cA = (const GAS char*)(cur.kind ? g.A2 : g.A) + (size_t)cur.pm * tsA; const GAS char* cB = (const GAS char*)(cur.kind ? g.Bt2 : g.Bt) + (size_t)cur.pn * tsB;
    PG8_STAGE(PG8_SB(0, 0), cB, voffB); PG8_STAGE(PG8_SB(0, 1), cB + hsB, voffB); PG8_STAGE(PG8_SA(0, 0), cA, voffA); PG8_STAGE(PG8_SA(0, 1), cA + hsA, voffA);
    if (wr == 1) PG8_BAR;
    PG8_WAIT_V(2); PG8_BAR;
    PG8_STAGE(PG8_SB(1, 0), cB + kstep, voffB); PG8_STAGE(PG8_SA(1, 0), cA + kstep, voffA); PG8_STAGE(PG8_SB(1, 1), cB + hsB + kstep, voffB);
    PG8_WAIT_V(6); PG8_BAR;
    for (;;) {
        const bool has_next = S.next(ui + 1, nxt);
        const GAS char* nA = has_next ? (const GAS char*)(nxt.kind ? g.A2 : g.A) + (size_t)nxt.pm * tsA : cA; const GAS char* nB = has_next ? (const GAS char*)(nxt.kind ? g.Bt2 : g.Bt) + (size_t)nxt.pn * tsB : cB;
#pragma nounroll
        for (int t = 0; t < nt; t += 2) {
            const bool last = (t == nt - 2);
            const GAS char* a1 = cA + (size_t)(t + 1) * kstep;
            const GAS char* a2 = last ? nA : cA + (size_t)(t + 2) * kstep; const GAS char* b2 = last ? nB : cB + (size_t)(t + 2) * kstep;
            const GAS char* a3 = a2 + kstep; const GAS char* b3 = b2 + kstep;
            PG8_LDB(B0, 0, 0); PG8_LDB(B1, 0, 1); PG8_SCHED; PG8_LDA(At, 0, 0); PG8_STAGE(PG8_SA(1, 1), a1 + hsA, voffA);
            PG8_WAIT_V(8); PG8_WAIT_L(0); PG8_BAR; PG8_MMA(0, 0, At, B0); PG8_MMA(0, 1, At, B1); PG8_BAR; PG8_SCHED;
            PG8_LDA(At, 0, 1); PG8_STAGE(PG8_SB(0, 0), b2, voffB); PG8_STAGE(PG8_SB(0, 1), b2 + hsB, voffB); PG8_STAGE(PG8_SA(0, 0), a2, voffA);
            PG8_WAIT_V(8); PG8_WAIT_L(0); PG8_BAR; PG8_MMA(1, 0, At, B0); PG8_MMA(1, 1, At, B1); PG8_BAR; PG8_SCHED;
            PG8_LDB(B0, 1, 0); PG8_LDB(B1, 1, 1); PG8_SCHED; PG8_LDA(At, 1, 0); PG8_STAGE(PG8_SA(0, 1), a2 + hsA, voffA);
            PG8_WAIT_V(8); PG8_WAIT_L(0); PG8_BAR; PG8_MMA(0, 0, At, B0); PG8_MMA(0, 1, At, B1); PG8_BAR; PG8_SCHED;
            PG8_LDA(At, 1, 1); PG8_STAGE(PG8_SB(1, 0), b3, voffB); PG8_STAGE(PG8_SB(1, 1), b3 + hsB, voffB); PG8_STAGE(PG8_SA(1, 0), a3, voffA);
            PG8_WAIT_V(8); PG8_WAIT_L(0); PG8_BAR; PG8_MMA(1, 0, At, B0); PG8_MMA(1, 1, At, B1); PG8_BAR; PG8_SCHED;
        }
        if constexpr (ALIGN_EPI) { if (wr == 0) PG8_BAR; }
        { int ln_; asm volatile("v_mbcnt_lo_u32_b32 %0, -1, 0\n\tv_mbcnt_hi_u32_b32 %0, -1, %0" : "=v"(ln_));
          E(acc, cur, wr, wc, ln_ & 15, ln_ >> 4); }
        if (!has_next) break;
#pragma unroll
        for (int a = 0; a < 2; ++a)
#pragma unroll
            for (int b = 0; b < 2; ++b)
#pragma unroll
                for (int m = 0; m < 4; ++m)
#pragma unroll
                    for (int n = 0; n < 2; ++n) acc[a][b][m][n] = (f32x4){0.f, 0.f, 0.f, 0.f};
        cur = nxt; cA = nA; cB = nB; ++ui;
        if constexpr (ALIGN_EPI) { if (wr == 1) PG8_BAR; }
    }
    PG8_WAIT_V(0);
    if constexpr (!ALIGN_EPI) { if (wr == 0) PG8_BAR; }
    PG8_BAR;
#undef PG8_SA
#undef PG8_SB
#undef PG8_STAGE
#undef PG8_LDA
#undef PG8_LDB
#undef PG8_MMA
#undef PG8_WAIT_V
#undef PG8_WAIT_L
#undef PG8_BAR
#undef PG8_SCHED
}
}

#define XB_TMO      128
#define XB_XCNT(j)  (256  + 64 * (j))
#define XB_XSUB(j)  (1280 + 64 * (j))
#define XB_XGEN(j)  (2304 + 64 * (j))
#define XB_TOP      3328
#define XB_TOPGEN   3392
#define XCD_BAR_WORDS 3456
#define XB_SPIN_CAP (1u << 21)
__device__ __forceinline__ unsigned xb_ld(unsigned* p)              { return __hip_atomic_load(p, __ATOMIC_RELAXED, __HIP_MEMORY_SCOPE_AGENT); }
__device__ __forceinline__ unsigned xb_add(unsigned* p, unsigned v) { return __hip_atomic_fetch_add(p, v, __ATOMIC_RELAXED, __HIP_MEMORY_SCOPE_AGENT); }
__device__ __forceinline__ unsigned xb_xcc_id() { return (unsigned)__builtin_amdgcn_s_getreg((3 << 11) | 20) & 0xFu; }
#define XB_SPIN(cond, bar) do { unsigned _sp = 0; while (cond) { __builtin_amdgcn_s_sleep(1); \
    if ((++_sp & 255u) == 0u) { if (xb_ld(&(bar)[XB_TMO])) break; if (_sp > XB_SPIN_CAP) { atomicAdd(&(bar)[XB_TMO], 1u); break; } } } } while (0)
struct XcdBarrier { unsigned* bar; unsigned x; volatile LAS unsigned* st; };
__device__ __forceinline__ XcdBarrier xcd_barrier_post(unsigned* bar, volatile LAS unsigned* st) {
    XcdBarrier b; b.bar = bar; b.x = xb_xcc_id(); b.st = st;
    if (threadIdx.x == 0) (void)xb_add(&bar[XB_XCNT(b.x)], 1u);
    return b;
}
__device__ __forceinline__ void xcd_barrier_complete(unsigned* bar, unsigned x, unsigned& nloc, unsigned& nx) {
    const unsigned G = gridDim.x * gridDim.y * gridDim.z;
    unsigned sum, cnt, mine, sp = 0u;
    for (;;) {
        sum = 0u; cnt = 0u; mine = 0u;
#pragma unroll
        for (unsigned j = 0; j < 16; ++j) { const unsigned c = xb_ld(&bar[XB_XCNT(j)]); sum += c; cnt += (c > 0u) ? 1u : 0u; mine = (j == x) ? c : mine; }
        if (sum == G) break;
        __builtin_amdgcn_s_sleep(1);
        if ((++sp & 255u) == 0u) { if (xb_ld(&bar[XB_TMO])) break; if (sp > XB_SPIN_CAP) { atomicAdd(&bar[XB_TMO], 1u); break; } }
    }
    nloc = mine > 0u ? mine : 1u; nx = cnt > 0u ? cnt : 1u;
}
__device__ __forceinline__ void xcd_barrier(const XcdBarrier& b) {
    asm volatile("s_waitcnt vmcnt(0)" ::: "memory");
    __syncthreads();
    const unsigned long long bp_ = (unsigned long long)b.bar; unsigned blo_ = __builtin_amdgcn_readfirstlane((unsigned)bp_), bhi_ = __builtin_amdgcn_readfirstlane((unsigned)(bp_ >> 32));
    asm volatile("" : "+s"(blo_), "+s"(bhi_)); unsigned* bar = (unsigned*)(((unsigned long long)bhi_ << 32) | blo_);
    if (threadIdx.x == 0) {
        __builtin_amdgcn_s_waitcnt(0);
        unsigned nloc = b.st[0], nx = b.st[1];
        if (nloc == 0u) { xcd_barrier_complete(bar, b.x, nloc, nx); b.st[0] = nloc; b.st[1] = nx; }
        const unsigned old = xb_add(&bar[XB_XSUB(b.x)], 1u);
        const unsigned gen = old / nloc;
        if (old + 1u == (gen + 1u) * nloc) {
            __builtin_amdgcn_fence(__ATOMIC_RELEASE, "agent");
            asm volatile("s_waitcnt vmcnt(0)" ::: "memory");
            const unsigned og = xb_add(&bar[XB_TOP], 1u);
            const unsigned tg = og / nx;
            if (og + 1u == (tg + 1u) * nx) {
#pragma unroll
                for (unsigned j = 0; j < 16; ++j) (void)__hip_atomic_fetch_add(&bar[XB_XGEN(j)], 1u, __ATOMIC_RELAXED, __HIP_MEMORY_SCOPE_AGENT); }
        }
        XB_SPIN(xb_ld(&bar[XB_XGEN(b.x)]) == gen, bar);
        __builtin_amdgcn_fence(__ATOMIC_ACQUIRE, "agent");
        asm volatile("s_waitcnt vmcnt(0)" ::: "memory");
    }
    __syncthreads();
}

constexpr size_t MiB = 1u << 20;
constexpr size_t WS_CTL = 0, CTL_ZERO_BYTES = 1 * MiB;
constexpr size_t WS_WIN = 1 * MiB;
constexpr size_t WS_WGLU = WS_WIN + 228 * MiB;
constexpr size_t WS_WRET = WS_WGLU + 32 * MiB;
constexpr size_t WS_WRWKV = WS_WRET + 16 * MiB;
constexpr size_t WS_WO = WS_WRWKV + 16 * MiB;
constexpr size_t WS_WUP = WS_WO + 32 * MiB;
constexpr size_t WS_WDOWN = WS_WUP + 176 * MiB;
constexpr size_t WS_WLR = WS_WDOWN + 88 * MiB;
constexpr size_t WS_MST = WS_WLR + 6 * MiB;
constexpr size_t WS_MIC = WS_MST + 32 * MiB;
constexpr size_t WS_AL = WS_MIC + 48 * MiB;
constexpr size_t WS_ROPE = WS_AL + 1 * MiB;
constexpr size_t WS_XB = WS_ROPE + 8 * MiB;
constexpr size_t WS_XF = WS_XB + 32 * MiB;
constexpr size_t WS_X1F = WS_XF + 64 * MiB;
constexpr size_t WS_X1B = WS_X1F + 64 * MiB;
constexpr size_t WS_U2 = WS_X1B + 33 * MiB;
constexpr size_t WS_RQ = WS_U2 + 24 * MiB;
constexpr size_t WS_RK = WS_RQ + 16 * MiB;
constexpr size_t WS_RKT = WS_RK + 16 * MiB;
constexpr size_t WS_RVT = WS_RKT + 16 * MiB;
constexpr size_t WS_RG = WS_RVT + 16 * MiB;
constexpr size_t WS_ZR = WS_RG + 16 * MiB;
constexpr size_t WS_GATES = WS_ZR + 52 * MiB;
constexpr size_t WS_SLOC = WS_GATES + 96 * MiB;
constexpr size_t WS_Z = WS_SLOC + 16 * MiB;
constexpr size_t WS_KVT = WS_Z + 16 * MiB;
constexpr size_t WS_PREVT = WS_KVT + 32 * MiB;
constexpr size_t WS_ORET = WS_PREVT + 16 * MiB;
constexpr size_t WS_ALR = WS_ORET + 16 * MiB;
constexpr size_t WS_DEC = WS_ALR + 4 * MiB;
constexpr size_t WS_AA = WS_DEC + 32 * MiB;
constexpr size_t WS_GG = WS_AA + 32 * MiB;
constexpr size_t WS_RW = WS_GG + 32 * MiB;
constexpr size_t WS_BONUS = WS_RW + 192 * MiB;
constexpr size_t WS_ORWKV = WS_BONUS + 1 * MiB;
constexpr size_t WS_MERGED = WS_ORWKV + 16 * MiB;
constexpr size_t WS_MERGEDB = WS_MERGED + 64 * MiB;
constexpr size_t WS_V1 = WS_MERGEDB + 32 * MiB;
constexpr size_t WS_AF = WS_V1 + 64 * MiB;
constexpr size_t WS_BF = WS_AF + 16 * MiB;
constexpr size_t WS_RT = WS_BF + 16 * MiB;
constexpr size_t WS_ARBT = WS_RT + 16 * MiB;
constexpr size_t WS_PL = WS_ARBT + 16 * MiB;
constexpr size_t WS_STATS2 = WS_PL + 2 * MiB;
constexpr size_t WS_STATS1 = WS_STATS2 + 1 * MiB;
constexpr size_t WS_C12 = WS_STATS1 + 1 * MiB;
constexpr size_t WS_PART = WS_C12 + 1 * MiB;
constexpr size_t WS_END = WS_PART + 28 * MiB;
constexpr size_t WS_VK2F = WS_V1;
constexpr size_t WS_S0B = WS_V1 + 32 * MiB;
constexpr size_t WS_XTB = WS_V1 + 48 * MiB;
constexpr size_t WS_Y0 = WS_RW + 160 * MiB;
constexpr size_t WS_M1 = WS_RW + 64 * MiB;
constexpr size_t WS_H = WS_RW;
constexpr size_t WS_HACT = WS_GATES;
constexpr int CW_BAR = 4096;

constexpr int RING_BYTES = 139264;
constexpr int LDSCTL_OFF = RING_BYTES, MISC_OFF = LDSCTL_OFF + 320;
constexpr int LDS_BASE = 1024;
constexpr int LDS_BYTES = 147456 + LDS_BASE;
constexpr int NWAVES = 8;

struct Ctx {
    LAS unsigned char* lds;
    int tid, lane, wave, vcu, G, gw, NGW, bx;
};
__device__ __forceinline__ int lane_id_now() { int l; asm volatile("v_mbcnt_lo_u32_b32 %0, -1, 0\n\tv_mbcnt_hi_u32_b32 %0, -1, %0" : "=v"(l)); return l; }
__device__ __forceinline__ Ctx fresh(const Ctx& c0) {
    Ctx c = c0; asm volatile("" : "+s"(c.wave), "+s"(c.vcu), "+s"(c.gw), "+s"(c.bx)); c.lane = lane_id_now(); c.tid = c.wave * 64 + c.lane; return c;
}
constexpr int PTAB_OFF = LDSCTL_OFF + 512;
__device__ __forceinline__ unsigned long long ptab(const Ctx& c, int k) {
    unsigned pb_ = LDS_BASE + PTAB_OFF; asm volatile("" : "+v"(pb_));
    const LAS unsigned* p = (const LAS unsigned*)(pb_ + 8 * k);
    const unsigned lo = __builtin_amdgcn_readfirstlane(p[0]), hi = __builtin_amdgcn_readfirstlane(p[1]);
    return ((unsigned long long)hi << 32) | lo;
}
__device__ __forceinline__ const GAS float* inp(const Ctx& c, int k) { return (const GAS float*)ptab(c, k); }
__device__ __forceinline__ GAS unsigned char* wsp(const Ctx& c) { return (GAS unsigned char*)ptab(c, 35); }
__device__ __forceinline__ GAS float* outp(const Ctx& c) { return (GAS float*)ptab(c, 36); }

constexpr int C12_STRIDE = 2 * NIN + 2 * 11264;
constexpr float ST_SCALE = 1048576.f, ST_INV = 1.f / 1048576.f;
typedef long long i64x2 __attribute__((ext_vector_type(2)));
__device__ __forceinline__ void row_stats(const GAS float* ST, int t, float& mu, float& rs) {
    const i64x2 a = *(const GAS i64x2*)((const GAS long long*)ST + (size_t)t * 2);
    const float s1 = (float)a.x * ST_INV, s2 = (float)a.y * ST_INV;
    mu = s1 * (1.f / D); rs = rsq(s2 * (1.f / D) - mu * mu + LN_EPS);
}
using pg8::Unit;
#define EPI_LOOP_ROWS for (int ai = 0; ai < 2; ++ai) _Pragma("unroll") for (int m = 0; m < 4; ++m)

struct EpiProj {
    GAS bf16 *U2, *RQ, *RK, *RG, *ZR, *GATES; const GAS float *ropeC, *ropeS, *ST, *C1, *C2;
    __device__ __forceinline__ void operator()(f32x4 (&acc)[2][2][4][2], const Unit& u, int wr, int wc, int fr, int fq) const {
        const int pn = u.pn, rowl = u.pm * 256 + wr * 64 + fr, cl = wc * 32 + 8 * fq;
        { f32x4 c1v[2][2], c2v[2][2];
#pragma unroll
          for (int bj = 0; bj < 2; ++bj)
#pragma unroll
              for (int n = 0; n < 2; ++n) { const int col = pn * 256 + bj * 128 + cl + 4 * n; c1v[bj][n] = *(const GAS f32x4*)(C1 + col); c2v[bj][n] = *(const GAS f32x4*)(C2 + col); }
          i64x2 st[2][4];
#pragma unroll
          EPI_LOOP_ROWS st[ai][m] = *(const GAS i64x2*)((const GAS long long*)ST + (size_t)(rowl + ai * 128 + m * 16) * 2);
#pragma unroll
          EPI_LOOP_ROWS { const float q1 = (float)st[ai][m].x * ST_INV, q2 = (float)st[ai][m].y * ST_INV, mu = q1 * (1.f / D), rs = rsq(q2 * (1.f / D) - mu * mu + LN_EPS);
#pragma unroll
              for (int bj = 0; bj < 2; ++bj)
#pragma unroll
                  for (int n = 0; n < 2; ++n) acc[ai][bj][m][n] = (acc[ai][bj][m][n] - c1v[bj][n] * mu) * rs + c2v[bj][n]; } }
        if (pn < 4) {
#pragma unroll
            EPI_LOOP_ROWS { const int t = rowl + ai * 128 + m * 16, n = t >> 4, tt = t & 15;
#pragma unroll
                for (int bj = 0; bj < 2; ++bj) { const int c = pn * 256 + bj * 128 + cl, g = c >> 4, half = (c >> 3) & 1;
                    *(GAS u32x4*)(U2 + ((size_t)(g * 512 + n) * 384 + tt * 16 + half * 8)) = pack8(acc[ai][bj][m][0], acc[ai][bj][m][1]); } }
        } else if (pn < 12) {
            const bool isk = pn >= 8; const int tb = pn - (isk ? 8 : 4), h = 2 * tb + (wc >> 1), i0 = 32 * (wc & 1) + 8 * fq;
            const float l2g = l2gamma(h);
            GAS bf16* dst = isk ? RK : RQ;
#pragma unroll
            for (int ai = 0; ai < 2; ++ai) { f32x4 rp[4][4];
#pragma unroll
              for (int m = 0; m < 4; ++m) { const int t = rowl + ai * 128 + m * 16; rp[m][0] = *(const GAS f32x4*)(ropeC + (size_t)t * 64 + i0); rp[m][1] = *(const GAS f32x4*)(ropeC + (size_t)t * 64 + i0 + 4);
                  rp[m][2] = *(const GAS f32x4*)(ropeS + (size_t)t * 64 + i0); rp[m][3] = *(const GAS f32x4*)(ropeS + (size_t)t * 64 + i0 + 4); }
#pragma unroll
              for (int m = 0; m < 4; ++m) { const int t = rowl + ai * 128 + m * 16; const float tl = (float)(t & 127);
                const float sc = isk ? ex2(-tl * l2g) * 0.08838834764831845f : ex2(tl * l2g);
                const f32x4 c0 = rp[m][0], c1 = rp[m][1], s0 = rp[m][2], s1 = rp[m][3];
                const f32x4 a0 = acc[ai][0][m][0], a1 = acc[ai][0][m][1], b0 = acc[ai][1][m][0], b1 = acc[ai][1][m][1];
                const f32x4 o10 = (a0 * c0 - b0 * s0) * sc, o11 = (a1 * c1 - b1 * s1) * sc, o20 = (b0 * c0 + a0 * s0) * sc, o21 = (b1 * c1 + a1 * s1) * sc;
                GAS bf16* p = dst + (size_t)t * 1024 + 128 * h + i0;
                *(GAS u32x4*)p = pack8(o10, o11); *(GAS u32x4*)(p + 64) = pack8(o20, o21); } }
        } else if (pn < 20) {
#pragma unroll
            EPI_LOOP_ROWS { const int t = rowl + ai * 128 + m * 16;
#pragma unroll
                for (int bj = 0; bj < 2; ++bj) { const f32x4 x0 = acc[ai][bj][m][0], x1 = acc[ai][bj][m][1];
                    *(GAS u32x4*)(RG + (size_t)t * 1024 + (pn - 16) * 256 + bj * 128 + cl) = pack8(x0 * sigm4(x0), x1 * sigm4(x1)); } }
        } else if (pn < 33) {
#pragma unroll
            EPI_LOOP_ROWS { const int t = rowl + ai * 128 + m * 16;
#pragma unroll
                for (int bj = 0; bj < 2; ++bj) *(GAS u32x4*)(ZR + (size_t)t * RWKV_IN + (pn - 20) * 256 + bj * 128 + cl) = pack8(acc[ai][bj][m][0], acc[ai][bj][m][1]); }
        } else {
#pragma unroll
            EPI_LOOP_ROWS { const int t = rowl + ai * 128 + m * 16;
#pragma unroll
                for (int bj = 0; bj < 2; ++bj) *(GAS u32x4*)(GATES + (size_t)t * 6144 + (pn - 33) * 256 + bj * 128 + cl) = pack8(sigm4(acc[ai][bj][m][0]), sigm4(acc[ai][bj][m][1])); }
        }
    }
};
struct EpiProjT {
    GAS bf16 *RKT, *RVT; const GAS float *ropeCT, *ropeST, *ST, *C1, *C2;
    __device__ __forceinline__ void operator()(f32x4 (&acc)[2][2][4][2], const Unit& u, int wr, int wc, int fr, int fq) const {
        const int pm = u.pm, h = 2 * pm + wr; const float l2g = l2gamma(h & 7);
#pragma unroll
        for (int bj = 0; bj < 2; ++bj) { const unsigned t0 = u.pn * 256 + bj * 128 + wc * 32 + 8 * fq; f32x4 mu0, mu1, rs0, rs1;
#pragma unroll
            for (int j = 0; j < 4; ++j) { float a, b; row_stats(ST, (int)t0 + j, a, b); mu0[j] = a; rs0[j] = b; row_stats(ST, (int)t0 + 4 + j, a, b); mu1[j] = a; rs1[j] = b; }
            f32x4 sc0, sc1; const float tl0 = (float)(t0 & 127u);
#pragma unroll
            for (int j = 0; j < 4; ++j) { sc0[j] = ex2(-(tl0 + (float)j) * l2g) * 0.08838834764831845f; sc1[j] = ex2(-(tl0 + (float)(j + 4)) * l2g) * 0.08838834764831845f; }
#pragma unroll
            for (int m = 0; m < 4; ++m) { const unsigned f0 = pm * 256 + wr * 64 + m * 16 + fr;
                const float c1a = C1[f0], c2a = C2[f0], c1b = C1[f0 + 128], c2b = C2[f0 + 128];
                const f32x4 a0 = (acc[0][bj][m][0] - mu0 * c1a) * rs0 + c2a, a1 = (acc[0][bj][m][1] - mu1 * c1a) * rs1 + c2a, b0 = (acc[1][bj][m][0] - mu0 * c1b) * rs0 + c2b, b1 = (acc[1][bj][m][1] - mu1 * c1b) * rs1 + c2b;
                if (pm < 4) { const unsigned i = 16 * m + fr, ro = i * (unsigned)T + t0;
                    const f32x4 c0 = *(const GAS f32x4*)(ropeCT + ro), c1 = *(const GAS f32x4*)(ropeCT + ro + 4), s0 = *(const GAS f32x4*)(ropeST + ro), s1 = *(const GAS f32x4*)(ropeST + ro + 4);
                    const unsigned o = (128u * h + i) * (unsigned)T + t0;
                    *(GAS u32x4*)(RKT + o) = pack8((a0 * c0 - b0 * s0) * sc0, (a1 * c1 - b1 * s1) * sc1); *(GAS u32x4*)(RKT + o + 64u * T) = pack8((b0 * c0 + a0 * s0) * sc0, (b1 * c1 + a1 * s1) * sc1); }
                else { const unsigned o = (f0 - 1024u) * (unsigned)T + t0; *(GAS u32x4*)(RVT + o) = pack8(a0, a1); *(GAS u32x4*)(RVT + o + 128u * T) = pack8(b0, b1); } }
            __builtin_amdgcn_sched_barrier(0); }
    }
};
struct EpiProjAll {
    EpiProj a; EpiProjT b;
    __device__ __forceinline__ void operator()(f32x4 (&acc)[2][2][4][2], const Unit& u, int wr, int wc, int fr, int fq) const {
        if (u.kind == 0) { asm volatile("" : "+v"(fr), "+v"(fq)); a(acc, u, wr, wc, fr, fq); } else { asm volatile("" : "+v"(fr), "+v"(fq)); b(acc, u, wr, wc, fr, fq); } }
};
struct EpiLR {
    GAS float* DEC; const GAS float *w0, *a0;
    __device__ __forceinline__ void operator()(const f32x4 (&acc)[2][2][4][2], const Unit& u, int wr, int wc, int fr, int fq) const {
        const int part = u.pn >> 2, rowl = u.pm * 256 + wr * 64 + fr;
        GAS float* dst = DEC + (size_t)part * ((size_t)T * 1024);
#pragma unroll
        for (int bj = 0; bj < 2; ++bj) { const int c = (u.pn & 3) * 256 + bj * 128 + wc * 32 + 8 * fq;
            f32x4 bv0 = (f32x4){0.f, 0.f, 0.f, 0.f}, bv1 = bv0;
            if (part == 0) { bv0 = *(const GAS f32x4*)(w0 + c); bv1 = *(const GAS f32x4*)(w0 + c + 4); }
            if (part == 1) { bv0 = *(const GAS f32x4*)(a0 + c); bv1 = *(const GAS f32x4*)(a0 + c + 4); }
#pragma unroll
            EPI_LOOP_ROWS { const int t = rowl + ai * 128 + m * 16; f32x4 v0 = acc[ai][bj][m][0] + bv0, v1 = acc[ai][bj][m][1] + bv1;
                if (part == 0) {
#pragma unroll
                    for (int j = 0; j < 4; ++j) { v0[j] = -0.6065306597126334f * sigm(v0[j]); v1[j] = -0.6065306597126334f * sigm(v1[j]); } }
                if (part == 1) { v0 = sigm4(v0); v1 = sigm4(v1); }
                if (part == 0) { *(GAS f32x4*)(dst + (size_t)t * 1024 + c) = v0; *(GAS f32x4*)(dst + (size_t)t * 1024 + c + 4) = v1; }
                else *(GAS u32x4*)((GAS bf16*)dst + (size_t)t * 1024 + c) = pack8(v0, v1); } }
    }
};
struct EpiS1 {
    GAS float* SLOC;
    __device__ __forceinline__ void operator()(const f32x4 (&acc)[2][2][4][2], const Unit& u, int wr, int wc, int fr, int fq) const {
        const int g = u.pn, nb = (u.pm & 1) * 256 + wr * 64 + fr, c = wc * 32 + 8 * fq;
#pragma unroll
        EPI_LOOP_ROWS { const int n = nb + ai * 128 + m * 16; GAS float* p = SLOC + (size_t)(g * 512 + n) * 128 + c;
            *(GAS f32x4*)p = acc[ai][0][m][0]; *(GAS f32x4*)(p + 4) = acc[ai][0][m][1]; }
    }
};
struct EpiS3 {
    const GAS bf16* U2; GAS bf16* Z; const GAS float* dsk;
    __device__ __forceinline__ void operator()(const f32x4 (&acc)[2][2][4][2], const Unit& u, int wr, int wc, int fr, int fq) const {
        const int g = u.pn, nb = (u.pm & 1) * 256 + wr * 64 + fr;
#pragma unroll
        for (int bj = 0; bj < 2; ++bj) { const int jj = bj * 128 + wc * 32 + 8 * fq, tt = jj >> 4, c0 = jj & 15, ch = 16 * g + c0;
            const f32x4 d0 = *(const GAS f32x4*)(dsk + ch), d1 = *(const GAS f32x4*)(dsk + ch + 4);
            u32x4 uv[2][4];
#pragma unroll
            EPI_LOOP_ROWS uv[ai][m] = *(const GAS u32x4*)(U2 + (size_t)(g * 512 + nb + ai * 128 + m * 16) * 384 + jj);
#pragma unroll
            EPI_LOOP_ROWS { const int n = nb + ai * 128 + m * 16;
                f32x4 u0, u1; unpack8(uv[ai][m], u0, u1);
                f32x4 y0 = acc[ai][bj][m][0] + d0 * u0, y1 = acc[ai][bj][m][1] + d1 * u1;
#pragma unroll
                for (int j = 0; j < 4; ++j) { y0[j] = gelu_tanh(y0[j]); y1[j] = gelu_tanh(y1[j]); }
                *(GAS u32x4*)(Z + (size_t)(16 * n + tt) * 1024 + ch) = pack8(y0, y1); } }
    }
};
template <int MODE> struct EpiMerge {
    GAS bf16* M0; GAS bf16* M1; GAS bf16* MERGEDB; const GAS bf16* GATES;
    __device__ __forceinline__ void operator()(const f32x4 (&acc)[2][2][4][2], const Unit& u, int wr, int wc, int fr, int fq) const {
        const int rowl = u.pm * 256 + wr * 64 + fr;
        if (MODE == 1) {
            const int c = u.pn * 128 + wc * 32 + 8 * fq; u32x4 gt[2][4];
#pragma unroll
            EPI_LOOP_ROWS gt[ai][m] = *(const GAS u32x4*)(GATES + (size_t)(rowl + ai * 128 + m * 16) * 6144 + c);
#pragma unroll
            EPI_LOOP_ROWS { const int t = rowl + ai * 128 + m * 16; f32x4 g0, g1; unpack8(gt[ai][m], g0, g1);
                *(GAS u32x4*)(M0 + (size_t)t * 2048 + c) = pack8(g0 * acc[ai][0][m][0] * sigm4(acc[ai][1][m][0]), g1 * acc[ai][0][m][1] * sigm4(acc[ai][1][m][1])); }
        } else if (MODE == 0) {
            u32x4 gt[2][4][2];
#pragma unroll
            EPI_LOOP_ROWS {
#pragma unroll
                for (int bj = 0; bj < 2; ++bj) gt[ai][m][bj] = *(const GAS u32x4*)(GATES + (size_t)(rowl + ai * 128 + m * 16) * 6144 + 2048 + u.pn * 256 + bj * 128 + wc * 32 + 8 * fq); }
#pragma unroll
            EPI_LOOP_ROWS { const int t = rowl + ai * 128 + m * 16;
#pragma unroll
                for (int bj = 0; bj < 2; ++bj) { const int c = u.pn * 256 + bj * 128 + wc * 32 + 8 * fq; const size_t o = (size_t)t * 2048 + c;
                    f32x4 g0, g1; unpack8(gt[ai][m][bj], g0, g1);
                    *(GAS u32x4*)(M1 + o) = pack8(g0 * acc[ai][bj][m][0], g1 * acc[ai][bj][m][1]); } }
        } else {
#pragma unroll
            for (int ai = 0; ai < 2; ++ai)
#pragma unroll
            for (int mp = 0; mp < 2; ++mp) { u32x4 gt[2][2], ma[2][2], mb[2][2];
#pragma unroll
                for (int mi = 0; mi < 2; ++mi)
#pragma unroll
                    for (int bj = 0; bj < 2; ++bj) { const int t = rowl + ai * 128 + (2 * mp + mi) * 16, c = u.pn * 256 + bj * 128 + wc * 32 + 8 * fq; const size_t o = (size_t)t * 2048 + c;
                        gt[mi][bj] = *(const GAS u32x4*)(GATES + (size_t)t * 6144 + 4096 + c); ma[mi][bj] = *(const GAS u32x4*)(M0 + o); mb[mi][bj] = *(const GAS u32x4*)(M1 + o); }
#pragma unroll
                for (int mi = 0; mi < 2; ++mi)
#pragma unroll
                    for (int bj = 0; bj < 2; ++bj) { const int m = 2 * mp + mi, t = rowl + ai * 128 + m * 16, c = u.pn * 256 + bj * 128 + wc * 32 + 8 * fq; const size_t o = (size_t)t * 2048 + c;
                        f32x4 g0, g1, a0, a1, b0, b1; unpack8(gt[mi][bj], g0, g1); unpack8(ma[mi][bj], a0, a1); unpack8(mb[mi][bj], b0, b1);
                        *(GAS u32x4*)(MERGEDB + o) = pack8(a0 + b0 + g0 * acc[ai][bj][m][0], a1 + b1 + g1 * acc[ai][bj][m][1]); } }
        }
    }
};
struct EpiMerge01 {
    EpiMerge<0> a; EpiMerge<1> b;
    __device__ __forceinline__ void operator()(const f32x4 (&acc)[2][2][4][2], const Unit& u, int wr, int wc, int fr, int fq) const {
        if (u.kind == 0) { asm volatile("" : "+v"(fr), "+v"(fq)); a(acc, u, wr, wc, fr, fq); } else { asm volatile("" : "+v"(fr), "+v"(fq)); b(acc, u, wr, wc, fr, fq); } }
};
struct EpiResidStats {
    const GAS float* Xraw; const GAS bf16* Hs; const GAS bf16* Ls; const GAS float* STs; const GAS float* gs; const GAS float* bs; GAS bf16* VB; GAS bf16* VL; GAS float* STo;
    __device__ __forceinline__ void operator()(f32x4 (&acc)[2][2][4][2], const Unit& u, int wr, int wc, int fr, int fq) const {
        const int rowl = u.pm * 256 + wr * 64 + fr;
        f32x4 gv[2][2], bv[2][2];
#pragma unroll
        for (int bj = 0; bj < 2; ++bj)
#pragma unroll
            for (int n = 0; n < 2; ++n) { const int col = u.pn * 256 + bj * 128 + wc * 32 + 8 * fq + 4 * n;
                gv[bj][n] = STs ? *(const GAS f32x4*)(gs + col) : (f32x4){1.f, 1.f, 1.f, 1.f}; bv[bj][n] = STs ? *(const GAS f32x4*)(bs + col) : (f32x4){0.f, 0.f, 0.f, 0.f}; }
#pragma unroll
        for (int ai = 0; ai < 2; ++ai)
#pragma unroll
        for (int mp = 0; mp < 2; ++mp) {
            i64x2 st[2]; u32x4 xa[2][2], xb[2][2];
#pragma unroll
            for (int mi = 0; mi < 2; ++mi) { const int m = 2 * mp + mi, t = rowl + ai * 128 + m * 16;
                if (STs) st[mi] = *(const GAS i64x2*)((const GAS long long*)STs + (size_t)t * 2);
#pragma unroll
                for (int bj = 0; bj < 2; ++bj) { const size_t o = (size_t)t * 2048 + u.pn * 256 + bj * 128 + wc * 32 + 8 * fq;
                    if (STs) { xa[mi][bj] = *(const GAS u32x4*)(Hs + o); xb[mi][bj] = RESID_LO ? *(const GAS u32x4*)(Ls + o) : (u32x4){0u, 0u, 0u, 0u}; }
                    else { xa[mi][bj] = *(const GAS u32x4*)(Xraw + o); xb[mi][bj] = *(const GAS u32x4*)(Xraw + o + 4); } } }
#pragma unroll
            for (int mi = 0; mi < 2; ++mi) { const int m = 2 * mp + mi, t = rowl + ai * 128 + m * 16; float mu = 0.f, rs = 1.f;
                if (STs) { const float q1 = (float)st[mi].x * ST_INV, q2 = (float)st[mi].y * ST_INV; mu = q1 * (1.f / D); rs = rsq(q2 * (1.f / D) - mu * mu + LN_EPS); }
                float s1 = 0.f, s2 = 0.f;
#pragma unroll
                for (int bj = 0; bj < 2; ++bj) { const size_t o = (size_t)t * 2048 + u.pn * 256 + bj * 128 + wc * 32 + 8 * fq;
                    f32x4 x0, x1;
                    if (STs) { f32x4 l0, l1; unpack8(xa[mi][bj], x0, x1); unpack8(xb[mi][bj], l0, l1); x0 += l0; x1 += l1; }
                    else { x0 = __builtin_bit_cast(f32x4, xa[mi][bj]); x1 = __builtin_bit_cast(f32x4, xb[mi][bj]); }
                    const f32x4 v0 = ((x0 - mu) * rs * gv[bj][0] + bv[bj][0]) * DN_ALPHA + acc[ai][bj][m][0], v1 = ((x1 - mu) * rs * gv[bj][1] + bv[bj][1]) * DN_ALPHA + acc[ai][bj][m][1];
                    const u32x4 hi = pack8(v0, v1); f32x4 h0, h1; unpack8(hi, h0, h1);
                    *(GAS u32x4*)(VB + o) = hi; if (RESID_LO) *(GAS u32x4*)(VL + o) = pack8(v0 - h0, v1 - h1);
                    const f32x4 w0 = RESID_LO ? v0 : h0, w1 = RESID_LO ? v1 : h1;
                    s1 += ((w0[0] + w0[1]) + (w0[2] + w0[3])) + ((w1[0] + w1[1]) + (w1[2] + w1[3]));
                    s2 += ((w0[0] * w0[0] + w0[1] * w0[1]) + (w0[2] * w0[2] + w0[3] * w0[3])) + ((w1[0] * w1[0] + w1[1] * w1[1]) + (w1[2] * w1[2] + w1[3] * w1[3])); }
                s1 += __shfl_xor(s1, 16); s1 += __shfl_xor(s1, 32); s2 += __shfl_xor(s2, 16); s2 += __shfl_xor(s2, 32);
                if (fq == 0) { GAS unsigned long long* so = (GAS unsigned long long*)STo + (size_t)t * 2;
                    __hip_atomic_fetch_add(so, (unsigned long long)(long long)(s1 * ST_SCALE), __ATOMIC_RELAXED, __HIP_MEMORY_SCOPE_AGENT); __hip_atomic_fetch_add(so + 1, (unsigned long long)(long long)(s2 * ST_SCALE), __ATOMIC_RELAXED, __HIP_MEMORY_SCOPE_AGENT); } } }
    }
};
__device__ __forceinline__ float dpp_ror1(float x) { return __builtin_bit_cast(float, __builtin_amdgcn_mov_dpp(__builtin_bit_cast(int, x), 0x121, 0xf, 0xf, true)); }
__device__ __forceinline__ float dpp_ror2(float x) { return __builtin_bit_cast(float, __builtin_amdgcn_mov_dpp(__builtin_bit_cast(int, x), 0x122, 0xf, 0xf, true)); }
struct EpiUpConv {
    GAS bf16* HA; const GAS float *ST, *C1, *C2, *wcv; LAS unsigned char* lds;
    __device__ __forceinline__ void operator()(f32x4 (&acc)[2][2][4][2], const Unit& u, int wr, int wc, int fr, int fq) const {
        const int tbase = 254 * u.pm - 2 + wr * 64 + fr, cl = wc * 32 + 8 * fq;
        { f32x4 c1v[2][2], c2v[2][2];
#pragma unroll
          for (int bj = 0; bj < 2; ++bj)
#pragma unroll
              for (int n = 0; n < 2; ++n) { const int col = u.pn * 256 + bj * 128 + cl + 4 * n; c1v[bj][n] = *(const GAS f32x4*)(C1 + col); c2v[bj][n] = *(const GAS f32x4*)(C2 + col); }
          i64x2 st[2][4];
#pragma unroll
          EPI_LOOP_ROWS { const int t = tbase + ai * 128 + m * 16, tc = t < 0 ? 0 : (t > T - 1 ? T - 1 : t); st[ai][m] = *(const GAS i64x2*)((const GAS long long*)ST + (size_t)tc * 2); }
#pragma unroll
          EPI_LOOP_ROWS { const int t = tbase + ai * 128 + m * 16; const bool ok = (t >= 0) && (t < T);
              const float q1 = (float)st[ai][m].x * ST_INV, q2 = (float)st[ai][m].y * ST_INV, mu = q1 * (1.f / D), rs = rsq(q2 * (1.f / D) - mu * mu + LN_EPS);
#pragma unroll
              for (int bj = 0; bj < 2; ++bj)
#pragma unroll
                  for (int n = 0; n < 2; ++n) { const f32x4 x = (acc[ai][bj][m][n] - c1v[bj][n] * mu) * rs + c2v[bj][n]; acc[ai][bj][m][n] = ok ? x : (f32x4){0.f, 0.f, 0.f, 0.f}; }
              __builtin_amdgcn_sched_barrier(0); } }
        const GAS float* wa = wcv + 128 * u.pn + cl;
        f32x4 w0a[2][2], w1a[2][2], w2a[2][2];
#pragma unroll
        for (int bj = 0; bj < 2; ++bj)
#pragma unroll
            for (int n = 0; n < 2; ++n) { const GAS float* p = wa + bj * 5632 + 4 * n; w0a[bj][n] = *(const GAS f32x4*)p; w1a[bj][n] = *(const GAS f32x4*)(p + 11264); w2a[bj][n] = *(const GAS f32x4*)(p + 2 * 11264); }
        LAS f32x4* HALO = (LAS f32x4*)(lds + 131072);
        if (fr >= 14) {
#pragma unroll
            for (int ai = 0; ai < 2; ++ai)
#pragma unroll
                for (int bj = 0; bj < 2; ++bj)
#pragma unroll
                    for (int n = 0; n < 2; ++n) HALO[(((((ai * 2 + wr) * 4 + wc) * 2 + bj) * 2 + n) * 4 + fq) * 2 + (fr - 14)] = acc[ai][bj][3][n]; }
        asm volatile("s_waitcnt lgkmcnt(0)" ::: "memory"); __builtin_amdgcn_s_barrier(); asm volatile("" ::: "memory");
#pragma unroll
        for (int bj = 0; bj < 2; ++bj) { f32x4 w0v[2], w1v[2], w2v[2];
#pragma unroll
            for (int n = 0; n < 2; ++n) { w0v[n] = w0a[bj][n]; w1v[n] = w1a[bj][n]; w2v[n] = w2a[bj][n]; }
#pragma unroll
            for (int ai = 0; ai < 2; ++ai) { const int sai = wr ? ai : (ai > 0 ? ai - 1 : 0), swr = wr ^ 1;
#pragma unroll
                for (int n = 0; n < 2; ++n) {
                    const int hb = (((((sai * 2 + swr) * 4 + wc) * 2 + bj) * 2 + n) * 4 + fq) * 2; const f32x4 h14 = HALO[hb], h15 = HALO[hb + 1];
                    asm volatile("" : "+v"(acc[ai][bj][0][n]), "+v"(acc[ai][bj][1][n]), "+v"(acc[ai][bj][2][n]), "+v"(acc[ai][bj][3][n]));
                    f32x4 c1r, c2r;
#pragma unroll
                    for (int e = 0; e < 4; ++e) { c1r[e] = dpp_ror1(acc[ai][bj][3][n][e]); c2r[e] = dpp_ror2(acc[ai][bj][3][n][e]); }
#pragma unroll
                    for (int m = 3; m >= 0; --m) { f32x4 q1 = h15, q2 = (fr == 0) ? h14 : h15;
                        if (m > 0) {
#pragma unroll
                            for (int e = 0; e < 4; ++e) { q1[e] = dpp_ror1(acc[ai][bj][m > 0 ? m - 1 : 0][n][e]); q2[e] = dpp_ror2(acc[ai][bj][m > 0 ? m - 1 : 0][n][e]); } }
                        const f32x4 p1 = (fr >= 1) ? c1r : q1, p2 = (fr >= 2) ? c2r : q2;
                        acc[ai][bj][m][n] = w0v[n] * p2 + w1v[n] * p1 + w2v[n] * acc[ai][bj][m][n];
                        c1r = q1; c2r = q2; }
                    asm volatile("" : "+v"(acc[ai][bj][0][n]), "+v"(acc[ai][bj][1][n]), "+v"(acc[ai][bj][2][n]), "+v"(acc[ai][bj][3][n]));
                    __builtin_amdgcn_sched_barrier(0); } } }
#pragma unroll
        EPI_LOOP_ROWS { const int t = tbase + ai * 128 + m * 16; const bool halo = (ai == 0) && (wr == 0) && (m == 0) && (fr < 2);
            if (!halo && t < T) { const f32x4 a0 = acc[ai][0][m][0], a1 = acc[ai][0][m][1];
                *(GAS u32x4*)(HA + (size_t)t * DFF + 128 * u.pn + cl) = pack8(a0 * sigm4(a0) * acc[ai][1][m][0], a1 * sigm4(a1) * acc[ai][1][m][1]); } }
    }
};
struct ProjOrder : pg8::StaticOrder {
    __device__ bool next(int i, Unit& u) const { if (!pg8::StaticOrder::next(i, u)) return false; if (u.pn >= 12) u.pn += 4; return true; }
};
struct GroupOrder {
    int G, c;
    __device__ bool next(int i, Unit& u) const { const int L = i * G + c; if (L >= 128) return false; u.pm = L; u.pn = L >> 1; u.kind = 0; return true; }
};
template <class S0, class S1> struct DualOrder {
    S0 a; S1 b; int n0, G, c;
    __device__ bool next(int i, Unit& u) const { const int L = i * G + c; if (L < n0) return a.next(L, u); if (!b.next(L - n0, u)) return false; u.kind = 1; return true; }
};

#ifndef PROBE_ID
#define PROBE_ID (-1)
#define PROBE_N 1
#endif
#define PRB(id) _Pragma("nounroll") for (int r_ = 0; r_ < ((id) == PROBE_ID ? PROBE_N : 1); ++r_)
__device__ __forceinline__ float wave_sum(float v) {
#pragma unroll
    for (int o = 1; o < 64; o <<= 1) v += __shfl_xor(v, o);
    return v;
}
#define LDS_WAIT() asm volatile("s_waitcnt lgkmcnt(0)" ::: "memory")

#ifndef DEFER_CONV
#define DEFER_CONV 1
#endif
#ifndef CONV_B1
#define CONV_B1 9500
#define CONV_B2 19000
#define CONV_B3 27000
#endif
__device__ __forceinline__ int dst_row(int mode, int n) {
    if (mode == 1) { if (n < 1024 || n >= 3072) return n; const int nl = n & 255, hh = nl >> 7, d = nl & 127; return (n - nl) + hh * 64 + (d & 63) + (d >> 6) * 128; }
    if (mode >= 2) { const int hn = (mode == 2) ? 2048 : 5632; return n < hn ? ((n >> 7) * 256 + (n & 127)) : (((n - hn) >> 7) * 256 + 128 + ((n - hn) & 127)); }
    return n;
}
constexpr int CONV_E0 = 32 * 456, CONV_E1 = CONV_E0 + 16 * 128, CONV_E2 = CONV_E1 + 16 * 64, CONV_E3 = CONV_E2 + 16 * 64, CONV_E4 = CONV_E3 + 32 * 64, CONV_E5 = CONV_E4 + 32 * 352, CONV_TOT = CONV_E5 + 88 * 64;
struct ConvItem { int m, K, N, kb, nb; };
__device__ __forceinline__ ConvItem conv_decode(int it) { ConvItem d; int r;
    if (it < CONV_E0) { d.m = 0; d.K = 2048; d.N = NIN; r = it; d.kb = r / 456; d.nb = r - d.kb * 456; }
    else if (it < CONV_E1) { d.m = 1; d.K = 1024; d.N = 4096; r = it - CONV_E0; d.kb = r >> 7; d.nb = r & 127; }
    else if (it < CONV_E2) { d.m = 2; d.K = 1024; d.N = 2048; r = it - CONV_E1; d.kb = r >> 6; d.nb = r & 63; }
    else if (it < CONV_E3) { d.m = 3; d.K = 1024; d.N = 2048; r = it - CONV_E2; d.kb = r >> 6; d.nb = r & 63; }
    else if (it < CONV_E4) { d.m = 4; d.K = 2048; d.N = 2048; r = it - CONV_E3; d.kb = r >> 6; d.nb = r & 63; }
    else if (it < CONV_E5) { d.m = 5; d.K = 2048; d.N = 11264; r = it - CONV_E4; d.kb = r / 352; d.nb = r - d.kb * 352; }
    else { d.m = 6; d.K = 5632; d.N = 2048; r = it - CONV_E5; d.kb = r >> 6; d.nb = r & 63; }
    return d;
}
__device__ __forceinline__ const GAS float* conv_src(const Ctx& c, int l, const ConvItem& d) {
    const int ii = d.m == 0 ? 2 : d.m == 1 ? 11 : d.m == 2 ? 14 : d.m == 3 ? 26 : d.m == 4 ? 27 : d.m == 5 ? 30 : 32;
    return inp(c, ii) + (size_t)l * ((size_t)d.K * d.N);
}
template <int CTRL> __device__ __forceinline__ float shl_dpp(float x) { return __builtin_bit_cast(float, __builtin_amdgcn_mov_dpp(__builtin_bit_cast(int, x), CTRL, 0xf, 0xf, true)); }
template <int DEP> __device__ __forceinline__ void conv_items(const Ctx& c0, int l, int b0, int b1, int wIdx, int nW) { const Ctx c = fresh(c0);
    LAS float* scr = (LAS float*)(c.lds + c.wave * 8704);
    LAS float* GB = (LAS float*)(c.lds + 8 * 8704);
    __syncthreads();
    { const int t4 = c.tid * 4; f32x4 gi = (f32x4){1.f, 1.f, 1.f, 1.f}, bi = (f32x4){0.f, 0.f, 0.f, 0.f};
      if (l > 0) { gi = *(const GAS f32x4*)(inp(c, 33) + (size_t)(l - 1) * D + t4); bi = *(const GAS f32x4*)(inp(c, 34) + (size_t)(l - 1) * D + t4); }
      const f32x4 gu = *(const GAS f32x4*)(inp(c, 28) + (size_t)l * D + t4), bu = *(const GAS f32x4*)(inp(c, 29) + (size_t)l * D + t4);
      *(LAS f32x4*)(GB + t4) = gi; *(LAS f32x4*)(GB + 2048 + t4) = bi; *(LAS f32x4*)(GB + 4096 + t4) = gu; *(LAS f32x4*)(GB + 6144 + t4) = bu; }
    __syncthreads();
    const int lane = c.lane, kr = lane >> 3, ns = lane & 7;
    int it = b0 + wIdx;
    if (it >= b1) return;
    const int last = b1 - 1;
    f32x4 q0[8], q1[8], q2[8], q3[8];
#define TR_LOAD(dst, item_) do { int item = (item_); item = item < last ? item : last; const ConvItem d_ = conv_decode(item); const GAS float* src_ = conv_src(c, l, d_) + (size_t)(64 * d_.kb + kr) * d_.N + 32 * d_.nb + 4 * ns; \
        _Pragma("unroll") for (int i = 0; i < 8; ++i) dst[i] = __builtin_nontemporal_load((const GAS f32x4*)(src_ + (size_t)(8 * i) * d_.N)); } while (0)
#define TR_PROC(src, item) do { \
        const ConvItem d = conv_decode(item); const int m = d.m, K = d.K, N = d.N, kb = d.kb, k0 = 64 * d.kb, n0 = 32 * d.nb; \
        const int mode = m == 0 ? 1 : m == 1 ? 2 : m == 5 ? 3 : 0; const bool fold = (m == 0) || (m == 5); \
        const size_t wsoff = m == 0 ? WS_WIN : m == 1 ? WS_WGLU : m == 2 ? WS_WRET : m == 3 ? WS_WRWKV : m == 4 ? WS_WO : m == 5 ? WS_WUP : WS_WDOWN; \
        GAS bf16* WT = (GAS bf16*)(wsp(c) + wsoff) + (size_t)l * ((size_t)K * N); \
        GAS float* P1 = (GAS float*)(wsp(c) + WS_PART) + (size_t)l * 64 * (NIN + 11264) + (m == 5 ? 64 * NIN : 0); GAS float* P2 = P1 + 32 * N;        \
        _Pragma("unroll") for (int i = 0; i < 8; ++i) { _Pragma("unroll") for (int e = 0; e < 4; ++e) scr[(8 * i + kr) * 33 + 4 * ns + e] = src[i][e]; } \
        LDS_WAIT(); asm volatile("" ::: "memory"); \
        const int cch = lane & 7; \
        f32x4 g0 = (f32x4){1.f, 1.f, 1.f, 1.f}, g1 = g0, b0v = (f32x4){0.f, 0.f, 0.f, 0.f}, b1v = b0v; \
        if (fold) { const LAS float* gb = GB + (m == 5 ? 4096 : 0) + k0 + 8 * cch; g0 = *(const LAS f32x4*)gb; g1 = *(const LAS f32x4*)(gb + 4); b0v = *(const LAS f32x4*)(gb + 2048); b1v = *(const LAS f32x4*)(gb + 2052); } \
        _Pragma("unroll") for (int j = 0; j < 4; ++j) { const int n = (lane >> 3) + 8 * j; const LAS float* sp = scr + (8 * cch) * 33 + n; \
            const f32x4 w0 = (f32x4){sp[0 * 33], sp[1 * 33], sp[2 * 33], sp[3 * 33]}, w1 = (f32x4){sp[4 * 33], sp[5 * 33], sp[6 * 33], sp[7 * 33]}; \
            const u32x4 o = pack8(w0 * g0, w1 * g1); const int dr = dst_row(mode, n0 + n); \
            __builtin_nontemporal_store(o, (GAS u32x4*)(WT + (size_t)dr * K + k0 + 8 * cch)); \
            if (fold) { f32x4 u0, u1; unpack8(o, u0, u1); const f32x4 e0 = w0 * b0v, e1 = w1 * b1v; \
                float p1 = ((u0[0] + u0[1]) + (u0[2] + u0[3])) + ((u1[0] + u1[1]) + (u1[2] + u1[3])), p2 = ((e0[0] + e0[1]) + (e0[2] + e0[3])) + ((e1[0] + e1[1]) + (e1[2] + e1[3])); \
                p1 += shl_dpp<0x101>(p1); p2 += shl_dpp<0x101>(p2); p1 += shl_dpp<0x102>(p1); p2 += shl_dpp<0x102>(p2); p1 += shl_dpp<0x104>(p1); p2 += shl_dpp<0x104>(p2);        \
                if (cch == 0) { P1[(size_t)kb * N + dr] = p1; P2[(size_t)kb * N + dr] = p2; } } } \
        LDS_WAIT(); asm volatile("" ::: "memory"); } while (0)
    if constexpr (DEP == 3) {
        TR_LOAD(q0, it); TR_LOAD(q1, it + nW); TR_LOAD(q2, it + 2 * nW);
#pragma nounroll
        for (;;) {
            TR_LOAD(q3, it + 3 * nW); TR_PROC(q0, it); it += nW; if (it >= b1) break;
            TR_LOAD(q0, it + 3 * nW); TR_PROC(q1, it); it += nW; if (it >= b1) break;
            TR_LOAD(q1, it + 3 * nW); TR_PROC(q2, it); it += nW; if (it >= b1) break;
            TR_LOAD(q2, it + 3 * nW); TR_PROC(q3, it); it += nW; if (it >= b1) break;
        }
    } else {
        TR_LOAD(q0, it);
#pragma nounroll
        for (;;) {
            TR_LOAD(q1, it + nW); TR_PROC(q0, it); it += nW; if (it >= b1) break;
            TR_LOAD(q0, it + nW); TR_PROC(q1, it); it += nW; if (it >= b1) break;
        }
    }
#undef TR_LOAD
#undef TR_PROC
}
__device__ __forceinline__ void ssm_prep_item(const Ctx& c, int l, int g) {
    LAS float* APOW = (LAS float*)c.lds;
    LAS float* BB = APOW + 17 * 128;
    LAS float* CC = BB + 2048;
    LAS float* KT = CC + 2048;
    LAS float* FF = KT + 4096;
    const int lg = l * 64 + g, tid = c.tid;
    const GAS float* b_re = inp(c, 6) + (size_t)lg * 1024; const GAS float* b_im = inp(c, 7) + (size_t)lg * 1024;
    const GAS float* c_re = inp(c, 8) + (size_t)lg * 1024; const GAS float* c_im = inp(c, 9) + (size_t)lg * 1024;
    if (tid < 64) {
        const float step = __expf(inp(c, 5)[lg]), lr = inp(c, 3)[lg * 64 + tid], li = inp(c, 4)[lg * 64 + tid];
        const float x = lr * step, y = li * step;
        for (int d = 0; d <= 16; ++d) { const float mag = __expf(x * (float)d), ang = y * (float)d; float sn, cs; sincos_cw(ang, sn, cs); APOW[(d * 64 + tid) * 2] = mag * cs; APOW[(d * 64 + tid) * 2 + 1] = mag * sn; }
        float sy, cy, sh, chh; sincos_cw(y, sy, cy); sincos_cw(0.5f * y, sh, chh);
        const float em1 = (fabsf(x) < 0.1f) ? x * (1.f + x * (0.5f + x * (0.16666667f + x * (0.041666668f + x * (0.0083333338f + x * 0.0013888889f))))) : (__expf(x) - 1.f);
        const float re1 = em1 * cy - 2.f * sh * sh, im1 = (em1 + 1.f) * sy, den = lr * lr + li * li;
        FF[tid * 2] = (re1 * lr + im1 * li) / den; FF[tid * 2 + 1] = (im1 * lr - re1 * li) / den;
    }
    __syncthreads();
    for (int idx = tid; idx < 1024; idx += 512) { const int p = idx >> 4; const float br = b_re[idx], bi = b_im[idx], fr = FF[p * 2], fi = FF[p * 2 + 1];
        BB[idx * 2] = fr * br - fi * bi; BB[idx * 2 + 1] = fr * bi + fi * br; CC[idx * 2] = c_re[idx]; CC[idx * 2 + 1] = c_im[idx]; }
    __syncthreads();
    for (int e = tid; e < 4096; e += 512) { const int d = e >> 8, ch = (e >> 4) & 15, c2 = e & 15; float s = 0.f;
        for (int p = 0; p < 64; ++p) { const float ar = APOW[(d * 64 + p) * 2], ai = APOW[(d * 64 + p) * 2 + 1], br = BB[(p * 16 + c2) * 2], bi = BB[(p * 16 + c2) * 2 + 1];
            const float er = ar * br - ai * bi, ei = ar * bi + ai * br; s += CC[(ch * 64 + p) * 2] * er - CC[(ch * 64 + p) * 2 + 1] * ei; }
        KT[e] = s; }
    __syncthreads();
    GAS bf16* MST = (GAS bf16*)(wsp(c) + WS_MST) + (size_t)lg * 65536;
    for (int e = tid; e < 8192; e += 512) { const int r = e >> 5, k8 = e & 31, j = k8 >> 1, c2b = (k8 & 1) * 8; float v[8];
#pragma unroll
        for (int q = 0; q < 8; ++q) { v[q] = 0.f;
            if (r < 128) { const int p = r & 63; const float ar = APOW[((15 - j) * 64 + p) * 2], ai = APOW[((15 - j) * 64 + p) * 2 + 1], br = BB[(p * 16 + c2b + q) * 2], bi = BB[(p * 16 + c2b + q) * 2 + 1];
                v[q] = (r < 64) ? (ar * br - ai * bi) : (ar * bi + ai * br); } }
        u32x4 o; o.x = cvt_pk_bf16(v[0], v[1]); o.y = cvt_pk_bf16(v[2], v[3]); o.z = cvt_pk_bf16(v[4], v[5]); o.w = cvt_pk_bf16(v[6], v[7]);
        *(GAS u32x4*)(MST + (size_t)r * 256 + k8 * 8) = o; }
    GAS bf16* MIC = (GAS bf16*)(wsp(c) + WS_MIC) + (size_t)lg * 98304;
    for (int e = tid; e < 12288; e += 512) { const int r = e / 48, k8 = e % 48, i = r >> 4, ch = r & 15; float v[8];
#pragma unroll
        for (int q = 0; q < 8; ++q) {
            if (k8 < 32) { const int j = k8 >> 1, c2 = (k8 & 1) * 8 + q; v[q] = (j <= i) ? KT[((i - j) * 16 + ch) * 16 + c2] : 0.f; }
            else { const int p = ((k8 - 32) & 7) * 8 + q; const float ar = APOW[((i + 1) * 64 + p) * 2], ai = APOW[((i + 1) * 64 + p) * 2 + 1], cr = CC[(ch * 64 + p) * 2], ci = CC[(ch * 64 + p) * 2 + 1];
                v[q] = (k8 < 40) ? (cr * ar - ci * ai) : -(cr * ai + ci * ar); } }
        u32x4 o; o.x = cvt_pk_bf16(v[0], v[1]); o.y = cvt_pk_bf16(v[2], v[3]); o.z = cvt_pk_bf16(v[4], v[5]); o.w = cvt_pk_bf16(v[6], v[7]);
        *(GAS u32x4*)(MIC + (size_t)r * 384 + k8 * 8) = o; }
    if (tid < 64) { GAS float* AL = (GAS float*)(wsp(c) + WS_AL) + (size_t)(lg * 64 + tid) * 2; AL[0] = APOW[(16 * 64 + tid) * 2]; AL[1] = APOW[(16 * 64 + tid) * 2 + 1]; }
    __syncthreads();
}
__device__ __forceinline__ void prologue(const Ctx& c0) { const Ctx c = fresh(c0);
    for (int it = c.bx; it < DEPTH * 64; it += c.G) ssm_prep_item(c, it >> 6, it & 63);
    const int gt = c.bx * 512 + c.tid, NT = c.G * 512;
    { const int* pos = (const int*)inp(c, 1); GAS float* rc = (GAS float*)(wsp(c) + WS_ROPE); GAS float* rs = rc + T * 64; GAS float* rct = rs + T * 64; GAS float* rst = rct + T * 64;
      for (int idx = gt; idx < T * 64; idx += NT) { const int t = idx >> 6, i = idx & 63; const float inv = ex2(-(float)i * (13.287712379549449f / 64.f)), ang = (float)pos[t] * inv;
          float cv, sv; sincos_cw(ang, sv, cv); rc[idx] = cv; rs[idx] = sv; }
      for (int idx = gt; idx < T * 64; idx += NT) { const int i = idx / T, t = idx % T; const float inv = ex2(-(float)i * (13.287712379549449f / 64.f)), ang = (float)pos[t] * inv;
          float cv, sv; sincos_cw(ang, sv, cv); rct[idx] = cv; rst[idx] = sv; } }
    for (int l = 0; l < DEPTH; ++l) { GAS bf16* WLR = (GAS bf16*)(wsp(c) + WS_WLR) + (size_t)l * 3072 * 256;
        const GAS float* w2 = inp(c, 17) + (size_t)l * 64 * 1024; const GAS float* a2 = inp(c, 19) + (size_t)l * 64 * 1024; const GAS float* g2 = inp(c, 20) + (size_t)l * 128 * 1024;
        for (int idx = gt; idx < 3072 * 32; idx += NT) { const int row = idx % 3072, k8 = idx / 3072, part = row >> 10, cc = row & 1023; float v[8];
#pragma unroll
            for (int q = 0; q < 8; ++q) { const int k = k8 * 8 + q; float x = 0.f;
                if (part == 0 && k < 64) x = w2[(size_t)k * 1024 + cc];
                if (part == 1 && k >= 64 && k < 128) x = a2[(size_t)(k - 64) * 1024 + cc];
                if (part == 2 && k >= 128) x = g2[(size_t)(k - 128) * 1024 + cc];
                v[q] = x; }
            u32x4 o; o.x = cvt_pk_bf16(v[0], v[1]); o.y = cvt_pk_bf16(v[2], v[3]); o.z = cvt_pk_bf16(v[4], v[5]); o.w = cvt_pk_bf16(v[6], v[7]);
            *(GAS u32x4*)(WLR + (size_t)row * 256 + k8 * 8) = o; } }
    { GAS long long* st = (GAS long long*)(wsp(c) + WS_STATS2);
      for (int idx = gt; idx < T * 2; idx += NT) st[idx] = (idx & 1) ? (long long)((double)D * (1.0 - 1e-5) * 1048576.0) : 0ll; }
    { GAS unsigned* z = (GAS unsigned*)(wsp(c) + WS_X1B); for (int idx = gt; idx < 2 * D / 2; idx += NT) z[idx] = 0u; }
    { const GAS float* x = inp(c, 0); GAS bf16* XB = (GAS bf16*)(wsp(c) + WS_XB);
      for (int idx0 = gt; idx0 < T * D / 8; idx0 += 4 * NT) { f32x4 a[4], b[4];
#pragma unroll
          for (int k = 0; k < 4; ++k) { const int idx = idx0 + k * NT; if (idx < T * D / 8) { a[k] = *(const GAS f32x4*)(x + (size_t)idx * 8); b[k] = *(const GAS f32x4*)(x + (size_t)idx * 8 + 4); } }
#pragma unroll
          for (int k = 0; k < 4; ++k) { const int idx = idx0 + k * NT; if (idx < T * D / 8) *(GAS u32x4*)(XB + (size_t)idx * 8) = pack8(a[k], b[k]); } } }
    __syncthreads();
    PRB(900) for (int l = 0; l < DEPTH; ++l) { const int p0 = (DEFER_CONV && l > 0) ? CONV_B3 : 0; if (p0 < CONV_TOT) conv_items<1>(c, l, p0, CONV_TOT, c.gw, c.NGW); }
}
__device__ __forceinline__ void c12_reduce(const Ctx& c0, int l0, int l1) { const Ctx c = fresh(c0);
    GAS float* C12 = (GAS float*)(wsp(c) + WS_C12); const GAS float* PART = (const GAS float*)(wsp(c) + WS_PART);
    for (int idx = l0 * C12_STRIDE + c.bx * 512 + c.tid; idx < l1 * C12_STRIDE; idx += c.G * 512) { const int l = idx / C12_STRIDE, r = idx % C12_STRIDE;
        const GAS float* p; int N;
        if (r < 2 * NIN) { N = NIN; p = PART + (size_t)l * 64 * (NIN + 11264) + (r < NIN ? r : 32 * NIN + (r - NIN)); }
        else { N = 11264; const int r2 = r - 2 * NIN; p = PART + (size_t)l * 64 * (NIN + 11264) + 64 * NIN + (r2 < 11264 ? r2 : 32 * 11264 + (r2 - 11264)); }
        float sacc = 0.f;
        float pv[32];
#pragma unroll
        for (int kb = 0; kb < 32; ++kb) pv[kb] = p[(size_t)kb * N];
#pragma unroll
        for (int kb = 0; kb < 32; ++kb) sacc += pv[kb];
        C12[idx] = sacc; }
}
__device__ __forceinline__ void ssm_scan(const Ctx& c0, int l) { const Ctx c = fresh(c0);
    const int gsel = (c.G >= 192) ? c.bx - 128 : c.bx;
    if (gsel < 0 || gsel >= 64) return;
    const int g = gsel, p = c.lane, w = c.wave;
    const GAS float* AL = (const GAS float*)(wsp(c) + WS_AL) + (size_t)((l * 64 + g) * 64 + p) * 2; const float ar = AL[0], ai = AL[1];
    const GAS float* SL = (const GAS float*)(wsp(c) + WS_SLOC) + (size_t)(g * 512 + 64 * w) * 128 + p; GAS bf16* U2 = (GAS bf16*)(wsp(c) + WS_U2) + (size_t)(g * 512 + 64 * w) * 384 + 256 + p;
    float lr[32], li[32];
    float er = 0.f, ei = 0.f;
#pragma nounroll
    for (int hf = 0; hf < 2; ++hf) {
#pragma unroll
        for (int q = 0; q < 32; ++q) { lr[q] = SL[(size_t)(32 * hf + q) * 128]; li[q] = SL[(size_t)(32 * hf + q) * 128 + 64]; }
#pragma unroll
        for (int q = 0; q < 32; ++q) { const float nr = ar * er - ai * ei + lr[q], ni = ar * ei + ai * er + li[q]; er = nr; ei = ni; } }
    float pr = ar, pi = ai;
#pragma unroll
    for (int q = 0; q < 6; ++q) { const float nr = pr * pr - pi * pi, ni = 2.f * pr * pi; pr = nr; pi = ni; }
    LAS float* EX = (LAS float*)c.lds;
    EX[(w * 64 + p) * 2] = er; EX[(w * 64 + p) * 2 + 1] = ei;
    __syncthreads();
    float sr = 0.f, si = 0.f;
    for (int v = 0; v < w; ++v) { const float xr = EX[(v * 64 + p) * 2], xi = EX[(v * 64 + p) * 2 + 1]; const float nr = pr * sr - pi * si + xr, ni = pr * si + pi * sr + xi; sr = nr; si = ni; }
    __syncthreads();
#pragma nounroll
    for (int hf = 0; hf < 2; ++hf) {
#pragma unroll
        for (int q = 0; q < 32; ++q) { lr[q] = SL[(size_t)(32 * hf + q) * 128]; li[q] = SL[(size_t)(32 * hf + q) * 128 + 64]; }
#pragma unroll
        for (int q = 0; q < 32; ++q) { U2[(size_t)(32 * hf + q) * 384] = f2bf(sr); U2[(size_t)(32 * hf + q) * 384 + 64] = f2bf(si);
            const float nr = ar * sr - ai * si + lr[q], ni = ar * si + ai * sr + li[q]; sr = nr; si = ni; } }
}
template <int CTRL> __device__ __forceinline__ float dpp_mov(float x) { return __builtin_bit_cast(float, __builtin_amdgcn_mov_dpp(__builtin_bit_cast(int, x), CTRL, 0xf, 0xf, true)); }
__device__ __forceinline__ float row16_sum(float x) { x += dpp_mov<0x121>(x); x += dpp_mov<0x122>(x); x += dpp_mov<0x124>(x); x += dpp_mov<0x128>(x); return x; }
__device__ __forceinline__ float wave_sum_dpp(float x) {
    x += dpp_mov<0x121>(x); x += dpp_mov<0x122>(x); x += dpp_mov<0x124>(x); x += dpp_mov<0x128>(x);
    const int xi = __builtin_bit_cast(int, x);
    return (__builtin_bit_cast(float, __builtin_amdgcn_readlane(xi, 0)) + __builtin_bit_cast(float, __builtin_amdgcn_readlane(xi, 16))) + (__builtin_bit_cast(float, __builtin_amdgcn_readlane(xi, 32)) + __builtin_bit_cast(float, __builtin_amdgcn_readlane(xi, 48)));
}
constexpr int RP = 136;
__device__ __forceinline__ void tile_fetch(u32x4 (&r)[4], const GAS bf16* g, size_t pitch, int tid) {
#pragma unroll
    for (int q = 0; q < 4; ++q) { const int idx = tid + 512 * q, row = idx >> 4, c8 = idx & 15; r[q] = *(const GAS u32x4*)(g + (size_t)row * pitch + c8 * 8); }
}
__device__ __forceinline__ void tile_commit(LAS bf16* s, const u32x4 (&r)[4], int tid) {
#pragma unroll
    for (int q = 0; q < 4; ++q) { const int idx = tid + 512 * q, row = idx >> 4, c8 = idx & 15; *(LAS u32x4*)(s + row * RP + c8 * 8) = r[q]; }
}
template <bool SWAP = false>
__device__ __forceinline__ void mm_rows16(f32x4 (&acc)[8], const LAS bf16* sA, const LAS bf16* sB, int w, int lane) {
    const int l15 = lane & 15, lq = lane >> 4;
#pragma unroll
    for (int ks = 0; ks < 4; ++ks) { const bf16x8 a = *(const LAS bf16x8*)(sA + (16 * w + l15) * RP + ks * 32 + 8 * lq);
#pragma unroll
        for (int ct = 0; ct < 8; ++ct) { const bf16x8 b = *(const LAS bf16x8*)(sB + (16 * ct + l15) * RP + ks * 32 + 8 * lq); acc[ct] = SWAP ? __builtin_amdgcn_mfma_f32_16x16x32_bf16(b, a, acc[ct], 0, 0, 0) : __builtin_amdgcn_mfma_f32_16x16x32_bf16(a, b, acc[ct], 0, 0, 0); } }
}
__device__ __forceinline__ void ret_kv_phase(const Ctx& c0) { const Ctx c = fresh(c0);
    LAS bf16* sA = (LAS bf16*)c.lds; LAS bf16* sB = sA + 128 * RP;
    const GAS bf16* RVT = (const GAS bf16*)(wsp(c) + WS_RVT); const GAS bf16* RKT = (const GAS bf16*)(wsp(c) + WS_RKT); GAS float* KVT = (GAS float*)(wsp(c) + WS_KVT);
    u32x4 ta[4], tb[4];
#define RKV_FETCH(it_) do { const int n_ = (it_) >> 3, h_ = (it_) & 7; tile_fetch(ta, RVT + (size_t)(128 * h_) * T + 128 * n_, T, c.tid); tile_fetch(tb, RKT + (size_t)(128 * h_) * T + 128 * n_, T, c.tid); } while (0)
    const bool bal = (c.G == 256);
#define RKV_ITEM(k_) (bal ? (c.bx < 128 ? ((k_) == 0 ? 384 + c.bx : -1) : ((k_) < 3 ? (c.bx - 128) + 128 * (k_) : -1)) : (c.bx + (k_) * c.G < 512 ? c.bx + (k_) * c.G : -1))
    int it = RKV_ITEM(0); if (it >= 0) RKV_FETCH(it);
    for (int k3 = 0; it >= 0; ++k3) { const int n = it >> 3, h = it & 7;
        tile_commit(sA, ta, c.tid); tile_commit(sB, tb, c.tid);
        __syncthreads();
        const int itn = RKV_ITEM(k3 + 1); if (itn >= 0) RKV_FETCH(itn);
        f32x4 acc[8];
#pragma unroll
        for (int ct = 0; ct < 8; ++ct) acc[ct] = (f32x4){0.f, 0.f, 0.f, 0.f};
        mm_rows16<true>(acc, sA, sB, c.wave, c.lane);
        GAS float* dst = KVT + (size_t)(n * 8 + h) * 16384; const int l15 = c.lane & 15, lq = c.lane >> 4;
#pragma unroll
        for (int ct = 0; ct < 8; ++ct) *(GAS f32x4*)(dst + (16 * c.wave + l15) * 128 + 16 * ct + 4 * lq) = acc[ct];
        __syncthreads(); it = itn; }
#undef RKV_ITEM
#undef RKV_FETCH
}
__device__ __forceinline__ void ret_scan_phase(const Ctx& c0) { const Ctx c = fresh(c0);
    const GAS float* KVT = (const GAS float*)(wsp(c) + WS_KVT); GAS bf16* PV = (GAS bf16*)(wsp(c) + WS_PREVT);
    for (int e = c.bx * 512 + c.tid; e < 8 * 16384; e += c.G * 512) { const int h = e >> 14;
        const float lg = l2gamma(h), g1 = ex2(lg), g127 = ex2(127.f * lg), g128 = ex2(128.f * lg);
        const int off = (h << 14) + (e & 16383); float st = 0.f;
        for (int n0 = 0; n0 < 64; n0 += 8) { float kv[8];
#pragma unroll
            for (int q = 0; q < 8; ++q) kv[q] = KVT[(size_t)(n0 + q) * 8 * 16384 + off];
#pragma unroll
            for (int q = 0; q < 8; ++q) { PV[(size_t)(n0 + q) * 8 * 16384 + off] = f2bf(g1 * st); st = g128 * st + g127 * kv[q]; } } }
}
__device__ __forceinline__ void ret_out_phase(const Ctx& c0, int l) { const Ctx c = fresh(c0);
    LAS bf16* sQ = (LAS bf16*)c.lds; LAS bf16* sK = sQ + 128 * RP; LAS bf16* sV = sK + 128 * RP; LAS bf16* sP = sV + 128 * RP;
    const GAS bf16* RQ = (const GAS bf16*)(wsp(c) + WS_RQ); const GAS bf16* RK = (const GAS bf16*)(wsp(c) + WS_RK); const GAS bf16* RVT = (const GAS bf16*)(wsp(c) + WS_RVT); const GAS bf16* PV = (const GAS bf16*)(wsp(c) + WS_PREVT);
    const GAS bf16* RG = (const GAS bf16*)(wsp(c) + WS_RG); GAS bf16* ORET = (GAS bf16*)(wsp(c) + WS_ORET);
    const GAS float* ng = inp(c, 12) + l * 1024; const GAS float* nb = inp(c, 13) + l * 1024;
    const int w = c.wave, l15 = c.lane & 15, lq = c.lane >> 4;
    const bool bal = (c.G == 256);
    u32x4 tq[4], tk[4], tv[4], tp[4];
#define ROUT_ITEM(k3_) (bal ? (c.bx < 128 ? ((k3_) == 0 ? 384 + c.bx : -1) : ((k3_) < 3 ? (c.bx - 128) + 128 * (k3_) : -1)) : (c.bx + (k3_) * c.G < 512 ? c.bx + (k3_) * c.G : -1))
#define ROUT_FETCH(it_) do { const int n_ = (it_) >> 3, h_ = (it_) & 7; tile_fetch(tq, RQ + (size_t)(128 * n_) * 1024 + 128 * h_, 1024, c.tid); tile_fetch(tk, RK + (size_t)(128 * n_) * 1024 + 128 * h_, 1024, c.tid); \
        tile_fetch(tv, RVT + (size_t)(128 * h_) * T + 128 * n_, T, c.tid); tile_fetch(tp, PV + (size_t)(n_ * 8 + h_) * 16384, 128, c.tid); } while (0)
    int it = ROUT_ITEM(0); if (it >= 0) ROUT_FETCH(it);
    for (int k3 = 0; it >= 0; ++k3) {
        const int n = it >> 3, h = it & 7;
        u32x2 rgv[8]; f32x4 ngv[8], nbv[8];
#pragma unroll
        for (int ct = 0; ct < 8; ++ct) { const int col = 128 * h + 16 * ct + 4 * lq; rgv[ct] = *(const GAS u32x2*)(RG + (size_t)(128 * n + 16 * w + l15) * 1024 + col); ngv[ct] = *(const GAS f32x4*)(ng + col); nbv[ct] = *(const GAS f32x4*)(nb + col); }
        tile_commit(sQ, tq, c.tid); tile_commit(sK, tk, c.tid); tile_commit(sV, tv, c.tid); tile_commit(sP, tp, c.tid);
        __syncthreads();
        const int itn = ROUT_ITEM(k3 + 1); if (itn >= 0) ROUT_FETCH(itn);
        f32x4 acc[8];
#pragma unroll
        for (int ct = 0; ct < 8; ++ct) acc[ct] = (f32x4){0.f, 0.f, 0.f, 0.f};
        mm_rows16(acc, sQ, sK, w, c.lane);
        __syncthreads();
#pragma unroll
        for (int ct = 0; ct < 8; ++ct)
#pragma unroll
            for (int r = 0; r < 4; ++r) { const int i = 16 * w + 4 * lq + r, j = 16 * ct + l15; sK[i * RP + j] = f2bf(j <= i ? acc[ct][r] : 0.f); }
        LDS_WAIT(); asm volatile("" ::: "memory");
#pragma unroll
        for (int ct = 0; ct < 8; ++ct) acc[ct] = (f32x4){0.f, 0.f, 0.f, 0.f};
        mm_rows16<true>(acc, sK, sV, w, c.lane);
        mm_rows16<true>(acc, sQ, sP, w, c.lane);
        { const int t = 128 * n + 16 * w + l15; f32x4 s4 = acc[0];
#pragma unroll
          for (int ct = 1; ct < 8; ++ct) s4 = s4 + acc[ct];
          float s = (s4[0] + s4[1]) + (s4[2] + s4[3]); s += __shfl_xor(s, 16); s += __shfl_xor(s, 32);
          const float mean = s * (1.f / 128.f); f32x4 q4 = (f32x4){0.f, 0.f, 0.f, 0.f};
#pragma unroll
          for (int ct = 0; ct < 8; ++ct) { const f32x4 d = acc[ct] - mean; q4 = q4 + d * d; }
          float q = (q4[0] + q4[1]) + (q4[2] + q4[3]); q += __shfl_xor(q, 16); q += __shfl_xor(q, 32);
          const float rstd = rsq(q * (1.f / 128.f) + GN_EPS);
#pragma unroll
          for (int ct = 0; ct < 8; ++ct) { const int col = 128 * h + 16 * ct + 4 * lq; const u32x2 rg = rgv[ct];
              const f32x4 gt = (f32x4){bf_lo(rg.x), bf_hi(rg.x), bf_lo(rg.y), bf_hi(rg.y)};
              const f32x4 o = ((acc[ct] - mean) * rstd * ngv[ct] + nbv[ct]) * gt;
              u32x2 ob; ob.x = cvt_pk_bf16(o[0], o[1]); ob.y = cvt_pk_bf16(o[2], o[3]); *(GAS u32x2*)(ORET + (size_t)t * 1024 + col) = ob; } }
        __syncthreads(); it = itn; }
#undef ROUT_ITEM
#undef ROUT_FETCH
}
__device__ __forceinline__ void rwkv_a_phase(const Ctx& c0, int l) { const Ctx c = fresh(c0);
    const GAS bf16* ZR = (const GAS bf16*)(wsp(c) + WS_ZR); GAS bf16* ALR = (GAS bf16*)(wsp(c) + WS_ALR); const GAS float* mu = inp(c, 15) + (size_t)l * RWKV_IN + 3072;
    const int NT = c.G * 512;
    for (int idx0 = c.bx * 512 + c.tid; idx0 < T * 32; idx0 += 2 * NT) {
        u32x4 zc[2], zp[2]; f32x4 m0[2], m1[2];
#pragma unroll
        for (int k = 0; k < 2; ++k) { const int idx = idx0 + k * NT; if (idx < T * 32) { const int t = idx >> 5, c8 = idx & 31;
            zc[k] = *(const GAS u32x4*)(ZR + (size_t)t * RWKV_IN + 3072 + c8 * 8); zp[k] = (u32x4){0u, 0u, 0u, 0u};
            if (t > 0) zp[k] = *(const GAS u32x4*)(ZR + (size_t)(t - 1) * RWKV_IN + 3072 + c8 * 8);
            m0[k] = *(const GAS f32x4*)(mu + c8 * 8); m1[k] = *(const GAS f32x4*)(mu + c8 * 8 + 4); } }
#pragma unroll
        for (int k = 0; k < 2; ++k) { const int idx = idx0 + k * NT; if (idx < T * 32) { const int t = idx >> 5, c8 = idx & 31;
            f32x4 z0, z1, p0, p1; unpack8(zc[k], z0, z1); unpack8(zp[k], p0, p1);
            f32x4 s0 = z0 + m0[k] * (p0 - z0), s1 = z1 + m1[k] * (p1 - z1);
            if (c8 < 8) {
#pragma unroll
                for (int j = 0; j < 4; ++j) { s0[j] = 2.f * sigm(2.f * s0[j]) - 1.f; s1[j] = 2.f * sigm(2.f * s1[j]) - 1.f; } }
            else if (c8 >= 16) { s0 = sigm4(s0); s1 = sigm4(s1); }
            *(GAS u32x4*)(ALR + (size_t)t * 256 + c8 * 8) = pack8(s0, s1); } } }
}
constexpr int RP2 = 72;
template <bool SWAP = false>
__device__ __forceinline__ f32x4 mm16(f32x4 acc, const LAS bf16* sA, const LAS bf16* sB, int lane) {
    const int l15 = lane & 15, q = lane >> 4;
#pragma unroll
    for (int s2 = 0; s2 < 2; ++s2) { const bf16x8 a = *(const LAS bf16x8*)(sA + l15 * RP2 + 32 * s2 + 8 * q), b = *(const LAS bf16x8*)(sB + l15 * RP2 + 32 * s2 + 8 * q);
        acc = SWAP ? __builtin_amdgcn_mfma_f32_16x16x32_bf16(b, a, acc, 0, 0, 0) : __builtin_amdgcn_mfma_f32_16x16x32_bf16(a, b, acc, 0, 0, 0); }
    return acc;
}
__device__ __forceinline__ u32x4 frag_kperm(const LAS bf16* srow, int s2, int q) {
    const u32x2 lo = *(const LAS u32x2*)(srow + 32 * s2 + 4 * q), hi = *(const LAS u32x2*)(srow + 32 * s2 + 16 + 4 * q); return (u32x4){lo.x, lo.y, hi.x, hi.y};
}
__device__ __forceinline__ void rw1_phase(const Ctx& c0, int l) { const Ctx c = fresh(c0);
    LAS bf16* sAt = (LAS bf16*)c.lds; LAS bf16* sBt = sAt + 64 * RP2; LAS bf16* sKt = sBt + 64 * RP2; LAS bf16* sRt = sKt + 64 * RP2; LAS bf16* sBtT = sRt + 64 * RP2; LAS bf16* sKtT = sBtT + 64 * RP2;
    LAS bf16* sVT = sKtT + 64 * RP2; LAS bf16* sAak = sVT + 64 * RP2; LAS bf16* sArb = sAak + 64 * RP2; LAS bf16* sArk = sArb + 64 * RP2; LAS bf16* sT = sArk + 64 * RP2; LAS bf16* sTT = sT + 64 * RP2;
    LAS bf16* sAab = sTT + 64 * RP2; LAS float* F = (LAS float*)(sAab + 64 * RP2); LAS float* SEG = F + 4096;
    LAS bf16* sUT = sKt; LAS bf16* sW1T = sAt; LAS bf16* sB2T = sBt;
#define RW1_BAR() do { asm volatile("s_waitcnt lgkmcnt(0)" ::: "memory"); __builtin_amdgcn_s_barrier(); asm volatile("" ::: "memory"); } while (0)
    float lw[8], av[8], prm[6]; bf16 zc[8][3], zp0[3];
#define RW1_FETCH(it2) do { const int h2 = (it2) >> 7, n2 = (it2) & 127, col2 = 64 * h2 + c.lane, t02 = 64 * n2 + 8 * c.wave; GAS unsigned char* ws2 = wsp(c); \
        { const GAS float* mu2 = inp(c, 15) + (size_t)l * RWKV_IN; prm[0] = mu2[col2]; prm[1] = mu2[1024 + col2]; prm[2] = mu2[2048 + col2]; prm[3] = (inp(c, 21) + l * 1024)[col2]; prm[4] = (inp(c, 22) + l * 1024)[col2]; prm[5] = (inp(c, 23) + l * 1024)[col2]; } \
        const GAS float* LW2 = (const GAS float*)(ws2 + WS_DEC); const GAS bf16* AA2 = (const GAS bf16*)(ws2 + WS_AA); const GAS bf16* zr2 = (const GAS bf16*)(ws2 + WS_ZR) + (size_t)t02 * RWKV_IN + col2; \
        _Pragma("unroll") for (int i = 0; i < 8; ++i) { const size_t g = (size_t)(t02 + i) * 1024 + col2; lw[i] = LW2[g]; av[i] = bf2f(AA2[g]); \
            _Pragma("unroll") for (int j = 0; j < 3; ++j) { zc[i][j] = zr2[(size_t)i * RWKV_IN + 1024 * j]; if (i == 0) zp0[j] = (t02 > 0) ? zr2[1024 * j - RWKV_IN] : (bf16)0; } } } while (0)
    if (c.bx < 2048) RW1_FETCH(c.bx);
    for (int it = c.bx; it < 2048; it += c.G) { const int h = it >> 7, n = it & 127; const size_t rec = (size_t)(h * 128 + n);
        int w_ = c.wave; asm volatile("" : "+s"(w_)); const int w = w_;
        int lane = c.lane; asm volatile("" : "+v"(lane)); const int tid = w * 64 + lane, l15 = lane & 15, q = lane >> 4;
        GAS unsigned char* ws = wsp(c);
        GAS bf16* BV = (GAS bf16*)(ws + WS_RW);
        PRB(410) { const int k = lane, seg = w, col = 64 * h + k; const int t0 = 64 * n + 8 * seg;
          const float mur = prm[0], muk = prm[1], muv = prm[2], kkc = prm[3], kac = prm[4], rkc = prm[5];
          float run = 0.f;
#pragma unroll
          for (int i = 0; i < 8; ++i) { run += lw[i]; F[(8 * seg + i) * 64 + k] = run; }
          SEG[seg * 64 + k] = run;
          RW1_BAR();
          float off = 0.f;
#pragma unroll
          for (int s2 = 0; s2 < 8; ++s2) off += (s2 < seg) ? SEG[s2 * 64 + k] : 0.f;
#pragma unroll
          for (int i = 0; i < 8; ++i) { const int l = 8 * seg + i; const float lp = F[l * 64 + k] + off, P = __expf(lp), Pm1 = __expf(lp - lw[i]), iP = __expf(-lp);
              float r = bf2f(zc[i][0]), kx = bf2f(zc[i][1]), v = bf2f(zc[i][2]);
              { const bf16 q0 = i ? zc[i > 0 ? i - 1 : 0][0] : zp0[0], q1 = i ? zc[i > 0 ? i - 1 : 0][1] : zp0[1], q2 = i ? zc[i > 0 ? i - 1 : 0][2] : zp0[2];
                r += mur * (bf2f(q0) - r); kx += muk * (bf2f(q1) - kx); v += muv * (bf2f(q2) - v); }
              const float a = av[i], kkr = kx * kkc, nrm = fmaxf(__builtin_amdgcn_sqrtf(wave_sum_dpp(kkr * kkr)), 1e-12f), kk = kkr * __builtin_amdgcn_rcpf(nrm);
              const float kp = kx * (1.f + (a - 1.f) * kac), bb = kk * a, bon = wave_sum_dpp(r * kp * rkc);
              BV[(size_t)(t0 + i) * 1024 + col] = f2bf(bon * v);
              const bf16 bt = f2bf(bb * iP), kt = f2bf(kp * iP);
              sAt[l * RP2 + k] = f2bf(-kk * Pm1); sBt[l * RP2 + k] = bt; sKt[l * RP2 + k] = kt; sRt[l * RP2 + k] = f2bf(r * P);
              sBtT[k * RP2 + l] = bt; sKtT[k * RP2 + l] = kt; sVT[k * RP2 + l] = f2bf(v);
              if (l == 63) ((GAS float*)(ws + WS_PL))[rec * 256 + k] = P; }
          if (it + c.G < 2048) RW1_FETCH(it + c.G);
          RW1_BAR(); }
        PRB(411) { const int p = w >> 1; const LAS bf16* pa = (p < 2) ? sAt : sRt; const LAS bf16* pb = (p & 1) ? sKt : sBt;
#pragma unroll
          for (int i8 = 0; i8 < 8; ++i8) { const int tt = (w & 1) * 8 + i8, mt = tt >> 2, nt = tt & 3;
              const f32x4 a = mm16((f32x4){0.f, 0.f, 0.f, 0.f}, pa + 16 * mt * RP2, pb + 16 * nt * RP2, lane);
#pragma unroll
              for (int r = 0; r < 4; ++r) { const int i = 16 * mt + 4 * q + r, j = 16 * nt + l15; const bool keep = (p < 2) ? (j < i) : (j <= i); const float x = keep ? a[r] : 0.f;
                  if (p == 0) { F[i * 64 + j] = x; sAab[i * RP2 + j] = f2bf(x); } else (p == 1 ? sAak : (p == 2 ? sArb : sArk))[i * RP2 + j] = f2bf(x); } }
          { const int f = tid >> 6, mt = f >> 1, s2 = f & 1; ((GAS u32x4*)(ws + WS_AF))[(rec * 8 + f) * 64 + lane] = frag_kperm(sAt + (16 * mt + l15) * RP2, s2, q); }
          { const int row = tid >> 3, c8 = tid & 7; *(GAS u32x4*)((GAS bf16*)(ws + WS_RT) + rec * 4096 + row * 64 + c8 * 8) = *(const LAS u32x4*)(sRt + row * RP2 + c8 * 8); }
          RW1_BAR(); }
        PRB(412) {
        if (w == 0) { const int b4 = lane >> 4, cc = lane & 15; const LAS float* Fb = F + (16 * b4) * 64 + 16 * b4; f32x4 Tr4[4], fr2[2][4];
            LAS bf16* sM1 = (LAS bf16*)SEG;
            { unsigned zz = 0u; asm volatile("" : "+v"(zz)); const u32x4 z4 = (u32x4){zz, zz, zz, zz};
#pragma unroll
              for (int e = 0; e < 9; ++e) { *(LAS u32x4*)(sT + (lane + 64 * e) * 8) = z4; *(LAS u32x4*)(sTT + (lane + 64 * e) * 8) = z4; }
              *(LAS u32x4*)(sM1 + lane * 8) = z4; *(LAS u32x4*)(sM1 + (lane + 64) * 8) = z4; }
            { float zf = 0.f; asm volatile("" : "+v"(zf));
#pragma unroll
              for (int j4 = 0; j4 < 4; ++j4) Tr4[j4] = (f32x4){zf, zf, zf, zf}; }
            Tr4[0][0] = fmaxf(0.f, 1.f - fabsf((float)cc)); sT[(16 * b4) * RP2 + 16 * b4 + cc] = f2bf(Tr4[0][0]);
            fr2[1][0] = *(const LAS f32x4*)(Fb + 64);
#pragma unroll
            for (int i = 1; i < 16; ++i) {
                if (i + 1 < 16) {
#pragma unroll
                    for (int j4 = 0; j4 < (i + 4) / 4; ++j4) fr2[(i + 1) & 1][j4] = *(const LAS f32x4*)(Fb + (i + 1) * 64 + 4 * j4); }
                f32x4 ac = (f32x4){fmaxf(0.f, 1.f - fabsf((float)cc - (float)i)), 0.f, 0.f, 0.f};
#pragma unroll
                for (int j4 = 0; j4 < (i + 3) / 4; ++j4) ac += fr2[i & 1][j4] * Tr4[j4];
                const float a = (ac[0] + ac[1]) + (ac[2] + ac[3]); Tr4[i >> 2][i & 3] = a; sT[(16 * b4 + i) * RP2 + 16 * b4 + cc] = f2bf(a); }
#pragma unroll
            for (int i8 = 0; i8 < 2; ++i8) { u32x4 o; o.x = cvt_pk_bf16(Tr4[2 * i8][0], Tr4[2 * i8][1]); o.y = cvt_pk_bf16(Tr4[2 * i8][2], Tr4[2 * i8][3]); o.z = cvt_pk_bf16(Tr4[2 * i8 + 1][0], Tr4[2 * i8 + 1][1]); o.w = cvt_pk_bf16(Tr4[2 * i8 + 1][2], Tr4[2 * i8 + 1][3]);
                *(LAS u32x4*)(sTT + (16 * b4 + cc) * RP2 + 16 * b4 + 8 * i8) = o; }
            asm volatile("s_waitcnt lgkmcnt(0)" ::: "memory");
#pragma unroll
            for (int hb = 0; hb < 2; ++hb) {
                const bf16x8 a = *(const LAS bf16x8*)(sAab + (32 * hb + 16 + l15) * RP2 + 32 * hb + 8 * q), b = *(const LAS bf16x8*)(sTT + (32 * hb + l15) * RP2 + 32 * hb + 8 * q);
                const f32x4 m4 = __builtin_amdgcn_mfma_f32_16x16x32_bf16(a, b, (f32x4){0.f, 0.f, 0.f, 0.f}, 0, 0, 0);
                u32x2 o; o.x = cvt_pk_bf16(m4[0], m4[1]); o.y = cvt_pk_bf16(m4[2], m4[3]); *(LAS u32x2*)(sM1 + hb * 512 + l15 * 32 + 16 + 4 * q) = o; }
            asm volatile("s_waitcnt lgkmcnt(0)" ::: "memory");
#pragma unroll
            for (int hb = 0; hb < 2; ++hb) {
                const bf16x8 a = *(const LAS bf16x8*)(sT + (32 * hb + 16 + l15) * RP2 + 32 * hb + 8 * q), b = *(const LAS bf16x8*)(sM1 + hb * 512 + l15 * 32 + 8 * q);
                const f32x4 t4v = __builtin_amdgcn_mfma_f32_16x16x32_bf16(a, b, (f32x4){0.f, 0.f, 0.f, 0.f}, 0, 0, 0);
#pragma unroll
                for (int r = 0; r < 4; ++r) sT[(32 * hb + 16 + 4 * q + r) * RP2 + 32 * hb + l15] = f2bf(t4v[r]);
                u32x2 o; o.x = cvt_pk_bf16(t4v[0], t4v[1]); o.y = cvt_pk_bf16(t4v[2], t4v[3]); *(LAS u32x2*)(sTT + (32 * hb + l15) * RP2 + 32 * hb + 16 + 4 * q) = o; }
            asm volatile("s_waitcnt lgkmcnt(0)" ::: "memory");
            LAS bf16* sMT = (LAS bf16*)SEG;
#pragma unroll
            for (int t4 = 0; t4 < 4; ++t4) { const int mt2 = t4 >> 1, nt2 = t4 & 1;
                const bf16x8 a = *(const LAS bf16x8*)(sAab + (32 + 16 * mt2 + l15) * RP2 + 8 * q), b = *(const LAS bf16x8*)(sTT + (16 * nt2 + l15) * RP2 + 8 * q);
                const f32x4 m4 = __builtin_amdgcn_mfma_f32_16x16x32_bf16(a, b, (f32x4){0.f, 0.f, 0.f, 0.f}, 0, 0, 0);
                u32x2 o; o.x = cvt_pk_bf16(m4[0], m4[1]); o.y = cvt_pk_bf16(m4[2], m4[3]); *(LAS u32x2*)(sMT + (16 * nt2 + l15) * 32 + 16 * mt2 + 4 * q) = o; }
            asm volatile("s_waitcnt lgkmcnt(0)" ::: "memory");
#pragma unroll
            for (int t4 = 0; t4 < 4; ++t4) { const int mt2 = t4 >> 1, nt2 = t4 & 1;
                const bf16x8 a = *(const LAS bf16x8*)(sT + (32 + 16 * mt2 + l15) * RP2 + 32 + 8 * q), b = *(const LAS bf16x8*)(sMT + (16 * nt2 + l15) * 32 + 8 * q);
                const f32x4 t4v = __builtin_amdgcn_mfma_f32_16x16x32_bf16(a, b, (f32x4){0.f, 0.f, 0.f, 0.f}, 0, 0, 0);
#pragma unroll
                for (int r = 0; r < 4; ++r) sT[(32 + 16 * mt2 + 4 * q + r) * RP2 + 16 * nt2 + l15] = f2bf(t4v[r]);
                u32x2 o; o.x = cvt_pk_bf16(t4v[0], t4v[1]); o.y = cvt_pk_bf16(t4v[2], t4v[3]); *(LAS u32x2*)(sTT + (16 * nt2 + l15) * RP2 + 32 + 16 * mt2 + 4 * q) = o; }
        } else {
            for (int tt = w - 1; tt < 16; tt += 7) { const int mt = tt >> 2, vt = tt & 3;
                const f32x4 a = mm16((f32x4){0.f, 0.f, 0.f, 0.f}, sAak + 16 * mt * RP2, sVT + 16 * vt * RP2, lane);
                u32x2 o; o.x = cvt_pk_bf16(a[0], a[1]); o.y = cvt_pk_bf16(a[2], a[3]); *(LAS u32x2*)(sUT + (16 * vt + l15) * RP2 + 16 * mt + 4 * q) = o; }
        }
        RW1_BAR(); }
        PRB(413) {
        if (w < 4) { const int vt = w;
#pragma unroll
            for (int mt = 0; mt < 4; ++mt) { const f32x4 a = mm16((f32x4){0.f, 0.f, 0.f, 0.f}, sT + 16 * mt * RP2, sUT + 16 * vt * RP2, lane);
                u32x2 o; o.x = cvt_pk_bf16(a[0], a[1]); o.y = cvt_pk_bf16(a[2], a[3]); *(LAS u32x2*)(sW1T + (16 * vt + l15) * RP2 + 16 * mt + 4 * q) = o; }
            asm volatile("s_waitcnt lgkmcnt(0)" ::: "memory");
#pragma unroll
            for (int mt = 0; mt < 4; ++mt) {
                f32x4 a = mm16<true>((f32x4){0.f, 0.f, 0.f, 0.f}, sArb + 16 * mt * RP2, sW1T + 16 * vt * RP2, lane); a = mm16<true>(a, sArk + 16 * mt * RP2, sVT + 16 * vt * RP2, lane);
                GAS bf16* dst = (GAS bf16*)(ws + WS_Y0) + rec * 4096;
                { u32x2 o; o.x = cvt_pk_bf16(a[0], a[1]); o.y = cvt_pk_bf16(a[2], a[3]); *(GAS u32x2*)(dst + (16 * mt + l15) * 64 + 16 * vt + 4 * q) = o; }
                f32x4 b = mm16((f32x4){0.f, 0.f, 0.f, 0.f}, sBtT + 16 * mt * RP2, sW1T + 16 * vt * RP2, lane); b = mm16(b, sKtT + 16 * mt * RP2, sVT + 16 * vt * RP2, lane);
                { u32x2 o; o.x = cvt_pk_bf16(b[0], b[1]); o.y = cvt_pk_bf16(b[2], b[3]); ((GAS u32x2*)(ws + WS_VK2F))[(rec * 16 + mt * 4 + vt) * 64 + lane] = o; } }
        } else { const int j = w - 4;
#pragma unroll
            for (int lt = 0; lt < 4; ++lt) { const f32x4 a = mm16((f32x4){0.f, 0.f, 0.f, 0.f}, sBtT + 16 * j * RP2, sTT + 16 * lt * RP2, lane);
#pragma unroll
                for (int r = 0; r < 4; ++r) sB2T[(16 * j + 4 * q + r) * RP2 + 16 * lt + l15] = f2bf(a[r]); }
            asm volatile("s_waitcnt lgkmcnt(0)" ::: "memory");
#pragma unroll
            for (int s2 = 0; s2 < 2; ++s2) ((GAS u32x4*)(ws + WS_BF))[(rec * 8 + 2 * j + s2) * 64 + lane] = frag_kperm(sB2T + (16 * j + l15) * RP2, s2, q);
            GAS bf16* dst = (GAS bf16*)(ws + WS_ARBT) + rec * 4096;
#pragma unroll
            for (int nt = 0; nt < 4; ++nt) { const f32x4 a = mm16<true>((f32x4){0.f, 0.f, 0.f, 0.f}, sArb + 16 * j * RP2, sTT + 16 * nt * RP2, lane);
                u32x2 o; o.x = cvt_pk_bf16(a[0], a[1]); o.y = cvt_pk_bf16(a[2], a[3]); *(GAS u32x2*)(dst + (16 * j + l15) * 64 + 16 * nt + 4 * q) = o; }
        }
        RW1_BAR(); } }
}
#undef RW1_BAR
#undef RW1_FETCH
__device__ __forceinline__ void rw2_phase(const Ctx& c0) { const Ctx c = fresh(c0);
    GAS unsigned char* ws = wsp(c); const int h = c.bx, w = c.wave, lane = c.lane, l15 = lane & 15, q = lane >> 4;
    constexpr int SLOT = 25 * 1024;
    LAS unsigned char* ring = c.lds;
#define RW2_BAR() do { __builtin_amdgcn_s_barrier(); asm volatile("" ::: "memory"); } while (0)
    if (w >= 4) {
        const int j = w & 3;
        const GAS char* gsrc = (j == 0) ? (const GAS char*)(ws + WS_AF) + (size_t)h * 128 * 8192 : (j == 1) ? (const GAS char*)(ws + WS_BF) + (size_t)h * 128 * 8192 : (j == 2) ? (const GAS char*)(ws + WS_VK2F) + (size_t)h * 128 * 8192 : (const GAS char*)(ws + WS_PL) + (size_t)h * 128 * 1024;
        gsrc += lane * 16;
#define RW2_ISSUE(n_) do { LAS unsigned char* sl_ = ring + ((n_) % 5) * SLOT; \
            if (j < 3) { _Pragma("unroll") for (int e = 0; e < 8; ++e) __builtin_amdgcn_global_load_lds((const GAS unsigned*)(gsrc + (size_t)(n_) * 8192 + e * 1024), (LAS unsigned*)(sl_ + j * 8192 + e * 1024), 16, 0, 0); } \
            else __builtin_amdgcn_global_load_lds((const GAS unsigned*)(gsrc + (size_t)(n_) * 1024), (LAS unsigned*)(sl_ + 24 * 1024), 16, 0, 0); } while (0)
#define RW2_WAIT(k8, k1) do { if (j == 3) asm volatile("s_waitcnt vmcnt(" #k1 ")" ::: "memory"); else asm volatile("s_waitcnt vmcnt(" #k8 ")" ::: "memory"); } while (0)
        RW2_ISSUE(0); RW2_ISSUE(1); RW2_ISSUE(2); RW2_ISSUE(3);
        RW2_WAIT(24, 3);
        RW2_BAR();
        for (int n = 0; n < 128; ++n) {
            if (n + 4 < 128) { RW2_ISSUE(n + 4); RW2_WAIT(24, 3); }
            else if (n + 3 < 128) RW2_WAIT(16, 2);
            else if (n + 2 < 128) RW2_WAIT(8, 1);
            else RW2_WAIT(0, 0);
            RW2_BAR();
        }
#undef RW2_ISSUE
#undef RW2_WAIT
    } else {
        const int vt = w;
        GAS bf16* S0B = (GAS bf16*)(ws + WS_S0B) + (size_t)h * 128 * 4096 + (16 * vt + l15) * 64 + 4 * q; GAS bf16* XTB = (GAS bf16*)(ws + WS_XTB) + (size_t)h * 128 * 4096 + (16 * vt + l15) * 64 + 4 * q;
        f32x4 S[4];
#pragma unroll
        for (int kt = 0; kt < 4; ++kt) S[kt] = (f32x4){0.f, 0.f, 0.f, 0.f};
        RW2_BAR();
        for (int n = 0; n < 128; ++n) {
            const LAS unsigned char* sl = ring + (n % 5) * SLOT;
            u32x4 caf[8], cbf[8]; f32x4 cvk[4], cpl[4];
#pragma unroll
            for (int f = 0; f < 8; ++f) caf[f] = *(const LAS u32x4*)(sl + f * 1024 + lane * 16);
#pragma unroll
            for (int f = 0; f < 8; ++f) cbf[f] = *(const LAS u32x4*)(sl + 8192 + f * 1024 + lane * 16);
#pragma unroll
            for (int kt = 0; kt < 4; ++kt) { const u32x2 vk = *(const LAS u32x2*)(sl + 16384 + (kt * 4 + vt) * 512 + lane * 8); cvk[kt] = (f32x4){bf_lo(vk.x), bf_hi(vk.x), bf_lo(vk.y), bf_hi(vk.y)};
                cpl[kt] = *(const LAS f32x4*)(sl + 24 * 1024 + (16 * kt + 4 * q) * 4); }
            u32x4 sb[2];
#pragma unroll
            for (int s2 = 0; s2 < 2; ++s2) { sb[s2].x = cvt_pk_bf16(S[2 * s2][0], S[2 * s2][1]); sb[s2].y = cvt_pk_bf16(S[2 * s2][2], S[2 * s2][3]); sb[s2].z = cvt_pk_bf16(S[2 * s2 + 1][0], S[2 * s2 + 1][1]); sb[s2].w = cvt_pk_bf16(S[2 * s2 + 1][2], S[2 * s2 + 1][3]);
                *(GAS u32x2*)(S0B + (size_t)n * 4096 + 32 * s2) = (u32x2){sb[s2].x, sb[s2].y}; *(GAS u32x2*)(S0B + (size_t)n * 4096 + 32 * s2 + 16) = (u32x2){sb[s2].z, sb[s2].w}; }
            f32x4 X[4];
#pragma unroll
            for (int mt = 0; mt < 4; ++mt) { X[mt] = (f32x4){0.f, 0.f, 0.f, 0.f};
#pragma unroll
                for (int s2 = 0; s2 < 2; ++s2) X[mt] = __builtin_amdgcn_mfma_f32_16x16x32_bf16(__builtin_bit_cast(bf16x8, caf[mt * 2 + s2]), __builtin_bit_cast(bf16x8, sb[s2]), X[mt], 0, 0, 0); }
            u32x4 xb[2];
#pragma unroll
            for (int s2 = 0; s2 < 2; ++s2) { xb[s2].x = cvt_pk_bf16(X[2 * s2][0], X[2 * s2][1]); xb[s2].y = cvt_pk_bf16(X[2 * s2][2], X[2 * s2][3]); xb[s2].z = cvt_pk_bf16(X[2 * s2 + 1][0], X[2 * s2 + 1][1]); xb[s2].w = cvt_pk_bf16(X[2 * s2 + 1][2], X[2 * s2 + 1][3]);
                *(GAS u32x2*)(XTB + (size_t)n * 4096 + 32 * s2) = (u32x2){xb[s2].x, xb[s2].y}; *(GAS u32x2*)(XTB + (size_t)n * 4096 + 32 * s2 + 16) = (u32x2){xb[s2].z, xb[s2].w}; }
#pragma unroll
            for (int kt = 0; kt < 4; ++kt) { f32x4 a = S[kt] + cvk[kt];
#pragma unroll
                for (int s2 = 0; s2 < 2; ++s2) a = __builtin_amdgcn_mfma_f32_16x16x32_bf16(__builtin_bit_cast(bf16x8, cbf[kt * 2 + s2]), __builtin_bit_cast(bf16x8, xb[s2]), a, 0, 0, 0);
                S[kt] = a * cpl[kt]; }
            asm volatile("s_waitcnt lgkmcnt(0)" ::: "memory");
            RW2_BAR();
        }
    }
#undef RW2_BAR
}
__device__ __forceinline__ void rw3_phase(const Ctx& c0, int l) { const Ctx c = fresh(c0);
    GAS unsigned char* ws = wsp(c); const int half = c.wave >> 2, wl = c.wave & 3, ht = c.tid & 255, lane = c.lane, l15 = lane & 15, q = lane >> 4;
    LAS bf16* sR = (LAS bf16*)c.lds + half * 4 * 64 * RP2; LAS bf16* sA2 = sR + 64 * RP2; LAS bf16* sS0 = sA2 + 64 * RP2; LAS bf16* sXT = sS0 + 64 * RP2;
    const GAS float* ng = inp(c, 24) + l * 1024; const GAS float* nb = inp(c, 25) + l * 1024;
    const GAS bf16* BV = (const GAS bf16*)(ws + WS_RW); const GAS bf16* GG = (const GAS bf16*)(ws + WS_GG); GAS bf16* O = (GAS bf16*)(ws + WS_ORWKV);
    u32x4 pf[8];
#define RW3_FETCH(rec_) do { _Pragma("unroll") for (int e = 0; e < 2; ++e) { const int idx = ht + 256 * e, row = idx >> 3, c8 = idx & 7; const size_t go = (size_t)(rec_) * 4096 + row * 64 + c8 * 8; \
        pf[4 * e] = *(const GAS u32x4*)((const GAS bf16*)(ws + WS_RT) + go); pf[4 * e + 1] = *(const GAS u32x4*)((const GAS bf16*)(ws + WS_ARBT) + go); \
        pf[4 * e + 2] = *(const GAS u32x4*)((const GAS bf16*)(ws + WS_S0B) + go); pf[4 * e + 3] = *(const GAS u32x4*)((const GAS bf16*)(ws + WS_XTB) + go); } } while (0)
    if (c.bx * 2 < 2048) { const int it0 = c.bx * 2 + half; RW3_FETCH((it0 >> 7) * 128 + (it0 & 127)); }
    for (int base = c.bx * 2; base < 2048; base += 2 * c.G) { const int it = base + half, h = it >> 7, n = it & 127; const size_t rec = (size_t)(h * 128 + n);
        const GAS bf16* y0 = (const GAS bf16*)(ws + WS_Y0) + rec * 4096; const int trow = 16 * wl + l15;
        u32x2 yv[4], bvv[4], ggv[4]; f32x4 ngv[4], nbv[4];
#pragma unroll
        for (int vt = 0; vt < 4; ++vt) { yv[vt] = *(const GAS u32x2*)(y0 + trow * 64 + 16 * vt + 4 * q);
            const int col = 64 * h + 16 * vt + 4 * q; const size_t o = (size_t)(64 * n + trow) * 1024 + col;
            bvv[vt] = *(const GAS u32x2*)(BV + o); ggv[vt] = *(const GAS u32x2*)(GG + o); ngv[vt] = *(const GAS f32x4*)(ng + col); nbv[vt] = *(const GAS f32x4*)(nb + col); }
#pragma unroll
        for (int e = 0; e < 2; ++e) { const int idx = ht + 256 * e, row = idx >> 3, c8 = idx & 7, lo = row * RP2 + c8 * 8;
            *(LAS u32x4*)(sR + lo) = pf[4 * e]; *(LAS u32x4*)(sA2 + lo) = pf[4 * e + 1]; *(LAS u32x4*)(sS0 + lo) = pf[4 * e + 2]; *(LAS u32x4*)(sXT + lo) = pf[4 * e + 3]; }
        __syncthreads();
        if (base + 2 * c.G < 2048) { const int itn = base + 2 * c.G + half; RW3_FETCH((itn >> 7) * 128 + (itn & 127)); }
        f32x4 acc[4];
#pragma unroll
        for (int vt = 0; vt < 4; ++vt) { const u32x2 y = yv[vt]; acc[vt] = (f32x4){bf_lo(y.x), bf_hi(y.x), bf_lo(y.y), bf_hi(y.y)};
            acc[vt] = mm16<true>(acc[vt], sR + 16 * wl * RP2, sS0 + 16 * vt * RP2, lane); acc[vt] = mm16<true>(acc[vt], sA2 + 16 * wl * RP2, sXT + 16 * vt * RP2, lane); }
        { const int t = 64 * n + trow; const f32x4 s4 = (acc[0] + acc[1]) + (acc[2] + acc[3]);
          float s1 = (s4[0] + s4[1]) + (s4[2] + s4[3]); s1 += __shfl_xor(s1, 16); s1 += __shfl_xor(s1, 32);
          const float mean = s1 * (1.f / 64.f); f32x4 q4 = (f32x4){0.f, 0.f, 0.f, 0.f};
#pragma unroll
          for (int vt = 0; vt < 4; ++vt) { const f32x4 d = acc[vt] - mean; q4 = q4 + d * d; }
          float qv = (q4[0] + q4[1]) + (q4[2] + q4[3]); qv += __shfl_xor(qv, 16); qv += __shfl_xor(qv, 32);
          const float rstd = rsq(qv * (1.f / 64.f) + RWKV_GN_EPS);
#pragma unroll
          for (int vt = 0; vt < 4; ++vt) { const int col = 64 * h + 16 * vt + 4 * q; const size_t o = (size_t)t * 1024 + col;
              const u32x2 bv = bvv[vt], gg = ggv[vt];
              const f32x4 bv4 = (f32x4){bf_lo(bv.x), bf_hi(bv.x), bf_lo(bv.y), bf_hi(bv.y)}, gg4 = (f32x4){bf_lo(gg.x), bf_hi(gg.x), bf_lo(gg.y), bf_hi(gg.y)};
              const f32x4 v = ((acc[vt] - mean) * rstd * ngv[vt] + nbv[vt] + bv4) * gg4;
              u32x2 ob; ob.x = cvt_pk_bf16(v[0], v[1]); ob.y = cvt_pk_bf16(v[2], v[3]); *(GAS u32x2*)(O + o) = ob; } }
        __syncthreads(); }
#undef RW3_FETCH
}
__device__ __forceinline__ void ln_phase(const Ctx& c0, const GAS bf16* VH, const GAS bf16* VLo, const GAS float* gam, const GAS float* bet, GAS float* OF) { const Ctx c = fresh(c0);
    f32x4 gmv[8], btv[8];
#pragma unroll
    for (int j = 0; j < 8; ++j) { const int col = (c.lane + 64 * j) * 4; gmv[j] = *(const GAS f32x4*)(gam + col); btv[j] = *(const GAS f32x4*)(bet + col); }
    for (int t0 = c.gw; t0 < T; t0 += 2 * c.NGW) {
        u32x2 ra[2][8], rb[2][8];
#pragma unroll
        for (int k = 0; k < 2; ++k) { const int t = t0 + k * c.NGW; if (t < T) { const GAS u32x2* rh = (const GAS u32x2*)(VH + (size_t)t * D) + c.lane; const GAS u32x2* rl = (const GAS u32x2*)(VLo + (size_t)t * D) + c.lane;
#pragma unroll
            for (int j = 0; j < 8; ++j) { ra[k][j] = rh[64 * j]; rb[k][j] = RESID_LO ? rl[64 * j] : (u32x2){0u, 0u}; } } }
#pragma unroll
        for (int k = 0; k < 2; ++k) { const int t = t0 + k * c.NGW; if (t < T) { f32x4 v[8]; float s = 0.f;
#pragma unroll
            for (int j = 0; j < 8; ++j) { const u32x2 a = ra[k][j], b = rb[k][j]; v[j] = (f32x4){bf_lo(a.x) + bf_lo(b.x), bf_hi(a.x) + bf_hi(b.x), bf_lo(a.y) + bf_lo(b.y), bf_hi(a.y) + bf_hi(b.y)}; s += (v[j][0] + v[j][1]) + (v[j][2] + v[j][3]); }
            const float mean = wave_sum(s) * (1.f / D); float q = 0.f;
#pragma unroll
            for (int j = 0; j < 8; ++j) { v[j] = v[j] - mean; q += (v[j][0] * v[j][0] + v[j][1] * v[j][1]) + (v[j][2] * v[j][2] + v[j][3] * v[j][3]); }
            const float rstd = rsq(wave_sum(q) * (1.f / D) + LN_EPS);
#pragma unroll
            for (int j = 0; j < 8; ++j) { const int col = (c.lane + 64 * j) * 4; const f32x4 o = v[j] * rstd * gmv[j] + btv[j];
                *(GAS f32x4*)(OF + (size_t)t * D + col) = o; } } } }
}
__device__ __forceinline__ void conv_phase(const Ctx& c0, int l) { const Ctx c = fresh(c0);
    const GAS bf16* H = (const GAS bf16*)(wsp(c) + WS_H); GAS bf16* HA = (GAS bf16*)(wsp(c) + WS_HACT); const GAS float* wc = inp(c, 31) + (size_t)l * 3 * 11264;
    for (int idx = c.bx * 512 + c.tid; idx < T * 704; idx += c.G * 512) { const int t = idx / 704, c8 = idx % 704, co = c8 * 8, hc = (co >> 7) * 256 + (co & 127);
        f32x4 a0 = (f32x4){0.f, 0.f, 0.f, 0.f}, a1 = a0, b0 = a0, b1 = a0;
#pragma unroll
        for (int j = 0; j < 3; ++j) { const int tt = t - 2 + j; if (tt >= 0) { f32x4 x0, x1, y0, y1;
                unpack8(*(const GAS u32x4*)(H + (size_t)tt * 11264 + hc), x0, x1); unpack8(*(const GAS u32x4*)(H + (size_t)tt * 11264 + hc + 128), y0, y1);
                const GAS float* wa = wc + j * 11264 + co; const GAS float* wb = wa + 5632;
                a0 += x0 * *(const GAS f32x4*)wa; a1 += x1 * *(const GAS f32x4*)(wa + 4); b0 += y0 * *(const GAS f32x4*)wb; b1 += y1 * *(const GAS f32x4*)(wb + 4); } }
        *(GAS u32x4*)(HA + (size_t)t * DFF + co) = pack8(a0 * sigm4(a0) * b0, a1 * sigm4(a1) * b1); }
}

#ifndef MK_SPLIT
#define MK_SPLIT 0
#endif
constexpr int NPH_LAYER = 10, NPH = 2 + DEPTH * NPH_LAYER + 1;
struct Args { const float* in[35]; float* out; unsigned char* ws; int ph_lo, ph_hi; };

__global__ void __launch_bounds__(NWAVES * 64, 2) fwd(Args args) {
    extern __shared__ __attribute__((aligned(16))) unsigned char lds_raw[];
    Ctx c;
    c.lds = (LAS unsigned char*)(unsigned)LDS_BASE; (void)lds_raw;
    c.wave = __builtin_amdgcn_readfirstlane((int)threadIdx.x >> 6); c.lane = lane_id_now(); c.tid = c.wave * 64 + c.lane;
    c.G = gridDim.x; c.bx = blockIdx.x; { const int bx = blockIdx.x; c.vcu = (c.G % 8 == 0) ? (bx % 8) * (c.G / 8) + bx / 8 : bx; }
    c.gw = c.vcu * NWAVES + c.wave; c.NGW = c.G * NWAVES;
    volatile LAS unsigned* MISC = (volatile LAS unsigned*)(unsigned)(LDS_BASE + MISC_OFF);
    for (int u = c.tid; u < (LDS_BYTES - LDS_BASE - LDSCTL_OFF) / 4; u += NWAVES * 64) ((LAS unsigned*)(c.lds + LDSCTL_OFF))[u] = 0u;
    __syncthreads();
    { LAS unsigned long long* tab = (LAS unsigned long long*)(unsigned)(LDS_BASE + PTAB_OFF);
#pragma unroll
      for (int i = 0; i < 35; ++i) if (c.tid == i) tab[i] = (unsigned long long)args.in[i];
      if (c.tid == 35) tab[35] = (unsigned long long)args.ws;
      if (c.tid == 36) tab[36] = (unsigned long long)args.out; }
    __syncthreads();
#if MK_SPLIT
    const int lo = args.ph_lo, hi = args.ph_hi;
#else
    constexpr int lo = 0, hi = NPH;
#endif
    if (hi - lo > 1) { const XcdBarrier b0 = xcd_barrier_post((unsigned*)(args.ws + WS_CTL) + CW_BAR, MISC + 8); if (c.tid == 0) MISC[10] = b0.x; }
    __syncthreads();
#define IN(k) (lo <= (k) && (k) < hi)
#define SEAM(k) do { if ((k) + 1 < hi) { XcdBarrier b_; b_.bar = (unsigned*)((GAS unsigned*)(wsp(c) + WS_CTL) + CW_BAR); b_.x = __builtin_amdgcn_readfirstlane(MISC[10]); b_.st = MISC + 8; xcd_barrier(b_); } } while (0)
    LAS unsigned char* ring = c.lds;
    const int bx0 = blockIdx.x;
#define CONV_SLOT(nunits, Gs, cidx, p0, p1) do { if (DEFER_CONV && l + 1 < DEPTH) { const int first_ = (nunits) % (Gs); if ((cidx) >= first_) { __syncthreads(); conv_items<3>(c, l + 1, (p0), (p1), ((cidx) - first_) * NWAVES + c.wave, ((Gs) - first_) * NWAVES); } } } while (0)

    if (IN(0)) { prologue(c); SEAM(0); }
    if (IN(1)) { c12_reduce(c, 0, DEFER_CONV ? 1 : DEPTH); SEAM(1); }

    for (int lay = 0; lay < DEPTH; ++lay) {
        const int pb = 2 + lay * NPH_LAYER;
        if (IN(pb + 0)) { int l = lay, bx = bx0; asm volatile("" : "+s"(l), "+s"(bx));
            PRB(0) { const GAS bf16* XBp = (const GAS bf16*)(wsp(c) + WS_XB); const GAS bf16* WINp = (const GAS bf16*)(wsp(c) + WS_WIN) + (size_t)l * NIN * D; const GAS float* C12p = (const GAS float*)(wsp(c) + WS_C12) + (size_t)l * C12_STRIDE;
              pg8::Gemm g{XBp, WINp, D, D, D, 256, WINp + (size_t)2048 * D, XBp};
              DualOrder<ProjOrder, pg8::StaticOrder> S; S.a.init(32, 53, 1, 0); S.b.init(8, 32, 1, 0); S.n0 = 32 * 53; S.G = c.G; S.c = bx;
              EpiProjAll E{EpiProj{(GAS bf16*)(wsp(c) + WS_U2), (GAS bf16*)(wsp(c) + WS_RQ), (GAS bf16*)(wsp(c) + WS_RK), (GAS bf16*)(wsp(c) + WS_RG), (GAS bf16*)(wsp(c) + WS_ZR), (GAS bf16*)(wsp(c) + WS_GATES),
                                   (const GAS float*)(wsp(c) + WS_ROPE), (const GAS float*)(wsp(c) + WS_ROPE) + T * 64, (const GAS float*)(wsp(c) + WS_STATS2), C12p, C12p + NIN},
                           EpiProjT{(GAS bf16*)(wsp(c) + WS_RKT), (GAS bf16*)(wsp(c) + WS_RVT), (const GAS float*)(wsp(c) + WS_ROPE) + 2 * T * 64, (const GAS float*)(wsp(c) + WS_ROPE) + 3 * T * 64, (const GAS float*)(wsp(c) + WS_STATS2), C12p + 2048, C12p + NIN + 2048}};
              pg8::gemm_phase<EpiProjAll, DualOrder<ProjOrder, pg8::StaticOrder>, true>(ring, g, S, E, c.wave); }
            CONV_SLOT(32 * 53 + 8 * 32, c.G, bx, 0, CONV_B1);
            SEAM(pb + 0);
        }
        if (IN(pb + 1)) { int l = lay, bx = bx0; asm volatile("" : "+s"(l), "+s"(bx));
            PRB(10) { pg8::Gemm g{(const GAS bf16*)(wsp(c) + WS_U2), (const GAS bf16*)(wsp(c) + WS_MST) + (size_t)l * 64 * 65536, 384, 256, 256};
              GroupOrder S{c.G, bx}; EpiS1 E{(GAS float*)(wsp(c) + WS_SLOC)};
              pg8::gemm_phase<EpiS1, GroupOrder, true>(ring, g, S, E, c.wave); }
            PRB(11) ret_kv_phase(c);
            PRB(12) rwkv_a_phase(c, l);
            { GAS long long* z1 = (GAS long long*)(wsp(c) + WS_STATS1); if (bx < T * 2 / 512) { long long zz = 0ll; asm volatile("" : "+v"(zz)); z1[bx * 512 + c.wave * 64 + lane_id_now()] = zz; } }
            SEAM(pb + 1);
        }
        if (IN(pb + 2)) { int l = lay, bx = bx0; asm volatile("" : "+s"(l), "+s"(bx));
            PRB(20) ssm_scan(c, l);
            PRB(21) ret_scan_phase(c);
            PRB(22) { pg8::Gemm g{(const GAS bf16*)(wsp(c) + WS_ALR), (const GAS bf16*)(wsp(c) + WS_WLR) + (size_t)l * 3072 * 256, 256, 256, 256};
              pg8::StaticOrder S; S.init(32, 12, c.G, bx);
              EpiLR E{(GAS float*)(wsp(c) + WS_DEC), inp(c, 16) + l * 1024, inp(c, 18) + l * 1024};
              pg8::gemm_phase<EpiLR, pg8::StaticOrder, true>(ring, g, S, E, c.wave); }
            SEAM(pb + 2);
        }
        if (IN(pb + 3)) { int l = lay, bx = bx0; asm volatile("" : "+s"(l), "+s"(bx));
            PRB(30) { pg8::Gemm g{(const GAS bf16*)(wsp(c) + WS_U2), (const GAS bf16*)(wsp(c) + WS_MIC) + (size_t)l * 64 * 98304, 384, 384, 384};
              GroupOrder S{c.G, bx}; EpiS3 E{(const GAS bf16*)(wsp(c) + WS_U2), (GAS bf16*)(wsp(c) + WS_Z), inp(c, 10) + l * 1024};
              pg8::gemm_phase<EpiS3, GroupOrder, true>(ring, g, S, E, c.wave); }
            PRB(31) ret_out_phase(c, l);
            PRB(41) rw1_phase(c, l);
            SEAM(pb + 3);
        }
        if (IN(pb + 4)) { int l = lay, bx = bx0; asm volatile("" : "+s"(l), "+s"(bx));
            if (bx < 16) { PRB(50) rw2_phase(c); }
            else { pg8::Gemm g{(const GAS bf16*)(wsp(c) + WS_ORET), (const GAS bf16*)(wsp(c) + WS_WRET) + (size_t)l * 2048 * 1024, 1024, 1024, 1024, 256, (const GAS bf16*)(wsp(c) + WS_Z), (const GAS bf16*)(wsp(c) + WS_WGLU) + (size_t)l * 4096 * 1024};
              DualOrder<pg8::StaticOrder, pg8::StaticOrder> S; S.a.init(32, 8, 1, 0); S.b.init(32, 16, 1, 0); S.n0 = 256; S.G = c.G - 16; S.c = bx - 16;
              EpiMerge01 E{EpiMerge<0>{(GAS bf16*)(wsp(c) + WS_MERGED), (GAS bf16*)(wsp(c) + WS_M1), (GAS bf16*)(wsp(c) + WS_MERGEDB), (const GAS bf16*)(wsp(c) + WS_GATES)},
                           EpiMerge<1>{(GAS bf16*)(wsp(c) + WS_MERGED), (GAS bf16*)(wsp(c) + WS_M1), (GAS bf16*)(wsp(c) + WS_MERGEDB), (const GAS bf16*)(wsp(c) + WS_GATES)}};
              pg8::gemm_phase<EpiMerge01, DualOrder<pg8::StaticOrder, pg8::StaticOrder>, true>(ring, g, S, E, c.wave);
              CONV_SLOT(32 * 8 + 32 * 16, c.G - 16, bx - 16, CONV_B1, CONV_B2); }
            SEAM(pb + 4);
        }
        if (IN(pb + 5)) { int l = lay, bx = bx0; asm volatile("" : "+s"(l), "+s"(bx)); PRB(60) rw3_phase(c, l); SEAM(pb + 5); }
        if (IN(pb + 6)) { int l = lay, bx = bx0; asm volatile("" : "+s"(l), "+s"(bx));
            PRB(70) { pg8::Gemm g{(const GAS bf16*)(wsp(c) + WS_ORWKV), (const GAS bf16*)(wsp(c) + WS_WRWKV) + (size_t)l * 2048 * 1024, 1024, 1024, 1024};
              pg8::StaticOrder S; S.init(32, 8, c.G, bx); EpiMerge<2> E{(GAS bf16*)(wsp(c) + WS_MERGED), (GAS bf16*)(wsp(c) + WS_M1), (GAS bf16*)(wsp(c) + WS_MERGEDB), (const GAS bf16*)(wsp(c) + WS_GATES)};
              pg8::gemm_phase<EpiMerge<2>, pg8::StaticOrder, true>(ring, g, S, E, c.wave); }
            SEAM(pb + 6);
        }
        if (IN(pb + 7)) { int l = lay, bx = bx0; asm volatile("" : "+s"(l), "+s"(bx));
            PRB(80) { pg8::Gemm g{(const GAS bf16*)(wsp(c) + WS_MERGEDB), (const GAS bf16*)(wsp(c) + WS_WO) + (size_t)l * 2048 * 2048, 2048, 2048, 2048};
              pg8::StaticOrder S; S.init(32, 8, c.G, bx);
              EpiResidStats E{inp(c, 0), (const GAS bf16*)(wsp(c) + WS_XB), (const GAS bf16*)(wsp(c) + WS_XF), (l == 0) ? (const GAS float*)nullptr : (const GAS float*)(wsp(c) + WS_STATS2), inp(c, 33) + (size_t)(l == 0 ? 0 : l - 1) * D, inp(c, 34) + (size_t)(l == 0 ? 0 : l - 1) * D,
                              (GAS bf16*)(wsp(c) + WS_X1B) + 2 * D, (GAS bf16*)(wsp(c) + WS_X1F), (GAS float*)(wsp(c) + WS_STATS1)};
              pg8::gemm_phase<EpiResidStats, pg8::StaticOrder, true>(ring, g, S, E, c.wave); }
            SEAM(pb + 7);
        }
        if (IN(pb + 8)) { int l = lay, bx = bx0; asm volatile("" : "+s"(l), "+s"(bx));
            PRB(90) { pg8::Gemm g{(const GAS bf16*)(wsp(c) + WS_X1B), (const GAS bf16*)(wsp(c) + WS_WUP) + (size_t)l * 11264 * 2048, 2048, 2048, 2048, 254};
              pg8::StaticOrder S; S.init(33, 44, c.G, bx);
              EpiUpConv E{(GAS bf16*)(wsp(c) + WS_HACT), (const GAS float*)(wsp(c) + WS_STATS1), (const GAS float*)(wsp(c) + WS_C12) + (size_t)l * C12_STRIDE + 2 * NIN, (const GAS float*)(wsp(c) + WS_C12) + (size_t)l * C12_STRIDE + 2 * NIN + 11264,
                          inp(c, 31) + (size_t)l * 3 * 11264, ring};
              pg8::gemm_phase<EpiUpConv, pg8::StaticOrder, true>(ring, g, S, E, c.wave); }
            { GAS long long* z2 = (GAS long long*)(wsp(c) + WS_STATS2); if (bx < T * 2 / 512) { long long zz = 0ll; asm volatile("" : "+v"(zz)); z2[bx * 512 + c.wave * 64 + lane_id_now()] = zz; } }
            CONV_SLOT(33 * 44, c.G, bx, CONV_B2, CONV_B3);
            SEAM(pb + 8);
        }
        if (IN(pb + 9)) { int l = lay, bx = bx0; asm volatile("" : "+s"(l), "+s"(bx));
            if (DEFER_CONV && l + 1 < DEPTH) c12_reduce(c, l + 1, l + 2);
            PRB(100) { pg8::Gemm g{(const GAS bf16*)(wsp(c) + WS_HACT), (const GAS bf16*)(wsp(c) + WS_WDOWN) + (size_t)l * 2048 * 5632, 5632, 5632, 5632};
              pg8::StaticOrder S; S.init(32, 8, c.G, bx);
              EpiResidStats E{inp(c, 0), (const GAS bf16*)(wsp(c) + WS_X1B) + 2 * D, (const GAS bf16*)(wsp(c) + WS_X1F), (const GAS float*)(wsp(c) + WS_STATS1), inp(c, 28) + (size_t)l * D, inp(c, 29) + (size_t)l * D,
                              (GAS bf16*)(wsp(c) + WS_XB), (GAS bf16*)(wsp(c) + WS_XF), (GAS float*)(wsp(c) + WS_STATS2)};
              pg8::gemm_phase<EpiResidStats, pg8::StaticOrder, true>(ring, g, S, E, c.wave); }
            SEAM(pb + 9);
        }
    }
    if (IN(NPH - 1)) { ln_phase(c, (const GAS bf16*)(wsp(c) + WS_XB), (const GAS bf16*)(wsp(c) + WS_XF), inp(c, 33) + (size_t)(DEPTH - 1) * D, inp(c, 34) + (size_t)(DEPTH - 1) * D, outp(c)); }
#undef IN
#undef SEAM
#undef CONV_SLOT
}

extern "C" void kernel_launch(void* const* d_in, const int* in_sizes, int n_in, void* d_out, int out_size, void* d_ws, size_t ws_size, hipStream_t stream) {
    static int grid = 0;
    if (grid == 0) {
        if (n_in != 35 || out_size != T * D || ws_size < WS_END) { fprintf(stderr, "kernel_launch: unexpected problem: n_in %d out %d ws %zu (need %zu)\n", n_in, out_size, ws_size, (size_t)WS_END); grid = -1; return; }
        int dev = 0, cus = 0, per_cu = 0;
        if (hipGetDevice(&dev) != hipSuccess || hipDeviceGetAttribute(&cus, hipDeviceAttributeMultiprocessorCount, dev) != hipSuccess) { grid = -1; return; }
        if (hipFuncSetAttribute((const void*)fwd, hipFuncAttributeMaxDynamicSharedMemorySize, LDS_BYTES) != hipSuccess) { fprintf(stderr, "kernel_launch: hipFuncSetAttribute failed\n"); grid = -1; return; }
        if (hipOccupancyMaxActiveBlocksPerMultiprocessor(&per_cu, (const void*)fwd, NWAVES * 64, LDS_BYTES) != hipSuccess || per_cu < 1) fprintf(stderr, "kernel_launch: occupancy query reports %d\n", per_cu);
        (void)hipGetLastError();
        grid = cus;
    }
    if (grid < 0) return;
    if (hipMemsetAsync((char*)d_ws + WS_CTL, 0, CTL_ZERO_BYTES, stream) != hipSuccess) return;
    Args a{};
    for (int i = 0; i < 35; ++i) a.in[i] = (const float*)d_in[i];
    a.out = (float*)d_out; a.ws = (unsigned char*)d_ws;
#if MK_SPLIT
    for (int p = 0; p < NPH; ++p) { a.ph_lo = p; a.ph_hi = p + 1; hipLaunchKernelGGL(fwd, dim3(grid), dim3(NWAVES * 64), LDS_BYTES, stream, a); }
#else
    a.ph_lo = 0; a.ph_hi = NPH;
    hipLaunchKernelGGL(fwd, dim3(grid), dim3(NWAVES * 64), LDS_BYTES, stream, a);
#endif
}
```
